# Optimizing an MI355X kernel written in HIP

```python
import math
import jax, jax.numpy as jnp
from jax import lax
import numpy as np

D_MODEL = 1024
BATCH = 16
SEQ = 2048
DEPTH = 1

RW_HEADS = 8
RW_HEAD_DIM = 64
RW_DIM = RW_HEADS * RW_HEAD_DIM
W_LORA = 64
A_LORA = 64
G_LORA = 128
GN_EPS = 64e-5
MLA_HEADS = 8
QK_NOPE = 64
QK_ROPE = 32
V_HEAD = 64
Q_LORA = 384
KV_LORA = 256
ROPE_THETA = 10000.0
Q_BLOCK = 128
N_GROUPS = 4
EXPERTS_PER_GROUP = 8
N_EXPERTS = N_GROUPS * EXPERTS_PER_GROUP
TOP_K = 2
D_EXPERT = 256
EXPERT_BLOCK = 256
NORM_EPS = 1e-6

RW_COLS = 3 * RW_DIM + W_LORA + A_LORA + G_LORA
MLA_COLS = Q_LORA + KV_LORA + QK_ROPE
GATE_COLS = 2 * D_MODEL
IN_COLS = RW_COLS + MLA_COLS + GATE_COLS

kernel_name = "hybrid_rwkv7_mla_hiermoe"


def rmsnorm(x, g):
    xf = x.astype(jnp.float32)
    y = xf * lax.rsqrt(jnp.mean(xf * xf, axis=-1, keepdims=True) + NORM_EPS)
    return (y * g.astype(jnp.float32)).astype(x.dtype)


def rope(t, cos, sin):
    t1, t2 = jnp.split(t, 2, axis=-1)
    return jnp.concatenate([t1 * cos - t2 * sin, t2 * cos + t1 * sin], axis=-1)


def rwkv7_mix(z_in, mu, w0, w_up, a0, a_up, g_up, k_k, k_a, r_k, gn_w, gn_b):
    B, S, _ = z_in.shape
    dt = z_in.dtype
    prev = jnp.pad(z_in, ((0, 0), (1, 0), (0, 0)))[:, :-1]
    z = z_in + (prev - z_in) * mu
    r, k, v, wd, ad, gd = jnp.split(
        z, [RW_DIM, 2 * RW_DIM, 3 * RW_DIM, 3 * RW_DIM + W_LORA, 3 * RW_DIM + W_LORA + A_LORA], axis=-1)
    w_log = -jax.nn.softplus(-(w0 + jnp.tanh(wd) @ w_up).astype(jnp.float32)) - 0.5
    decay = jnp.exp(-jnp.exp(w_log))
    a = jax.nn.sigmoid(a0 + ad @ a_up)
    g = jax.nn.sigmoid(gd) @ g_up

    def heads(t):
        return t.reshape(B, S, RW_HEADS, RW_HEAD_DIM).astype(jnp.float32)

    kk = heads(k * k_k)
    kk = kk / jnp.maximum(jnp.sqrt(jnp.sum(kk * kk, axis=-1, keepdims=True)), 1e-12)
    k = k * (1.0 + (a - 1.0) * k_a)
    r_h, k_h, v_h, a_h, w_h = heads(r), heads(k), heads(v), heads(a), heads(decay)

    def step(state, inp):
        r_t, w_t, k_t, v_t, kk_t, a_t = inp
        sa = jnp.einsum('bhvk,bhk->bhv', state, -kk_t)
        state = (state * w_t[:, :, None, :]
                 + sa[..., None] * (kk_t * a_t)[:, :, None, :]
                 + v_t[..., None] * k_t[:, :, None, :])
        return state, jnp.einsum('bhvk,bhk->bhv', state, r_t)

    xs = tuple(jnp.moveaxis(t, 1, 0) for t in (r_h, w_h, k_h, v_h, kk, a_h))
    s0 = jnp.zeros((B, RW_HEADS, RW_HEAD_DIM, RW_HEAD_DIM), jnp.float32)
    _, ys = lax.scan(step, s0, xs)
    y = jnp.moveaxis(ys, 0, 1)
    mean = jnp.mean(y, axis=-1, keepdims=True)
    var = jnp.mean(jnp.square(y - mean), axis=-1, keepdims=True)
    y = ((y - mean) * lax.rsqrt(var + GN_EPS)).reshape(B, S, RW_DIM)
    y = y * gn_w.astype(jnp.float32) + gn_b.astype(jnp.float32)
    bonus = jnp.sum(r_h * k_h * r_k.astype(jnp.float32), axis=-1, keepdims=True) * v_h
    y = y + bonus.reshape(B, S, RW_DIM)
    return (y * g.astype(jnp.float32)).astype(dt)


def mla_mix(q_d, kv_d, kr_raw, cos, sin, g_qa, w_q_up, g_kva, w_kv_up):
    B, S, _ = q_d.shape
    q = (rmsnorm(q_d, g_qa) @ w_q_up).reshape(B, S, MLA_HEADS, QK_NOPE + QK_ROPE)
    q_nope, q_rope = q[..., :QK_NOPE], q[..., QK_NOPE:]
    kv = (rmsnorm(kv_d, g_kva) @ w_kv_up).reshape(B, S, MLA_HEADS, QK_NOPE + V_HEAD)
    k_nope, v = kv[..., :QK_NOPE], kv[..., QK_NOPE:]
    q_rope = rope(q_rope, cos[:, :, None, :], sin[:, :, None, :])
    k_rope = rope(kr_raw, cos, sin)
    scale = 1.0 / math.sqrt(QK_NOPE + QK_ROPE)
    outs = []
    for start in range(0, S, Q_BLOCK):
        end = min(start + Q_BLOCK, S)
        s = (jnp.einsum('bqhd,bkhd->bhqk', q_nope[:, start:end], k_nope[:, :end])
             + jnp.einsum('bqhr,bkr->bhqk', q_rope[:, start:end], k_rope[:, :end]))
        s = s.astype(jnp.float32) * scale
        causal = jnp.arange(end)[None, :] <= jnp.arange(start, end)[:, None]
        p = jax.nn.softmax(jnp.where(causal, s, -jnp.inf), axis=-1).astype(v.dtype)
        outs.append(jnp.einsum('bhqk,bkhd->bqhd', p, v[:, :end]))
    return jnp.concatenate(outs, axis=1).reshape(B, S, MLA_HEADS * V_HEAD)


def hier_moe(h, w_group, b_group, w_router, b_router, w_gu, w_down):
    B, S, D = h.shape
    N = B * S
    hf = h.reshape(N, D)
    p_group = jax.nn.softmax((hf @ w_group).astype(jnp.float32) + b_group.astype(jnp.float32), axis=-1)
    g_sel = jnp.argmax(p_group, axis=-1)
    gate_g = jnp.take_along_axis(p_group, g_sel[:, None], axis=-1)
    fine = ((hf @ w_router).astype(jnp.float32) + b_router.astype(jnp.float32)
            ).reshape(N, N_GROUPS, EXPERTS_PER_GROUP)
    fine_sel = jnp.take_along_axis(fine, g_sel[:, None, None], axis=1)[:, 0]
    top_v, top_i = lax.top_k(fine_sel, TOP_K)
    gate = jax.nn.softmax(top_v, axis=-1) * gate_g
    expert = g_sel[:, None] * EXPERTS_PER_GROUP + top_i

    A = N * TOP_K
    e_flat = expert.reshape(A)
    t_flat = jnp.arange(A) // TOP_K
    w_flat = gate.reshape(A)
    order = jnp.argsort(e_flat)
    e_s, t_s, w_s = e_flat[order], t_flat[order], w_flat[order]
    counts = jnp.bincount(e_flat, length=N_EXPERTS)
    starts = jnp.cumsum(counts) - counts
    padded = (counts + EXPERT_BLOCK - 1) // EXPERT_BLOCK * EXPERT_BLOCK
    pad_end = jnp.cumsum(padded)
    pad_start = pad_end - padded
    dest = pad_start[e_s] + (jnp.arange(A) - starts[e_s])
    n_blocks = -(-A // EXPERT_BLOCK) + N_EXPERTS
    P = n_blocks * EXPERT_BLOCK
    tok_buf = jnp.full((P,), N, jnp.int32).at[dest].set(t_s.astype(jnp.int32))
    w_buf = jnp.zeros((P,), jnp.float32).at[dest].set(w_s)
    blk_expert = jnp.minimum(
        jnp.searchsorted(pad_end, jnp.arange(n_blocks) * EXPERT_BLOCK, side='right'), N_EXPERTS - 1)
    x_pad = jnp.concatenate([hf, jnp.zeros((1, D), hf.dtype)], axis=0)
    xb = x_pad[tok_buf].reshape(n_blocks, EXPERT_BLOCK, D)

    def expert_block(args):
        xblk, e = args
        gt, up = jnp.split(xblk @ w_gu[e], 2, axis=-1)
        return (jax.nn.silu(gt) * up) @ w_down[e]

    yb = lax.map(expert_block, (xb, blk_expert)).reshape(P, D)
    out = jnp.zeros((N + 1, D), h.dtype).at[tok_buf].add(yb * w_buf[:, None].astype(h.dtype))
    return out[:N].reshape(B, S, D)


def setup_inputs(seed: int = 0) -> dict:
    key = jax.random.key(seed)
    ks = jax.random.split(key, 32)
    f32 = jnp.float32

    def nrm(k, shape, scale):
        return jax.random.normal(k, shape, f32) * scale

    L, D = DEPTH, D_MODEL
    x = jax.random.normal(ks[0], (BATCH, SEQ, D), f32)
    offsets = jax.random.randint(ks[1], (BATCH, 1), 0, 1024, dtype=jnp.int32)
    positions = offsets + jnp.arange(SEQ, dtype=jnp.int32)[None, :]
    return {
        "x": x,
        "positions": positions,
        "mix_norm_g": 1.0 + nrm(ks[2], (L, D), 0.02),
        "w_in": nrm(ks[3], (L, D, IN_COLS), D ** -0.5),
        "rw_mu": jax.random.uniform(ks[4], (L, RW_COLS), f32),
        "rw_w0": jax.random.uniform(ks[5], (L, RW_DIM), f32, -6.0, -1.0),
        "rw_w_up": nrm(ks[6], (L, W_LORA, RW_DIM), 0.1 * W_LORA ** -0.5),
        "rw_a0": nrm(ks[7], (L, RW_DIM), 0.1),
        "rw_a_up": nrm(ks[8], (L, A_LORA, RW_DIM), 0.5 * A_LORA ** -0.5),
        "rw_g_up": nrm(ks[9], (L, G_LORA, RW_DIM), G_LORA ** -0.5),
        "rw_k_k": 0.85 + nrm(ks[10], (L, RW_DIM), 0.02),
        "rw_k_a": 1.0 + nrm(ks[11], (L, RW_DIM), 0.02),
        "rw_r_k": nrm(ks[12], (L, RW_HEADS, RW_HEAD_DIM), 0.1),
        "rw_gn_w": 1.0 + nrm(ks[13], (L, RW_DIM), 0.02),
        "rw_gn_b": nrm(ks[14], (L, RW_DIM), 0.02),
        "mla_g_qa": 1.0 + nrm(ks[15], (L, Q_LORA), 0.02),
        "mla_w_q_up": nrm(ks[16], (L, Q_LORA, MLA_HEADS * (QK_NOPE + QK_ROPE)), Q_LORA ** -0.5),
        "mla_g_kva": 1.0 + nrm(ks[17], (L, KV_LORA), 0.02),
        "mla_w_kv_up": nrm(ks[18], (L, KV_LORA, MLA_HEADS * (QK_NOPE + V_HEAD)), KV_LORA ** -0.5),
        "w_branch_rw": nrm(ks[19], (L, RW_DIM, D), RW_DIM ** -0.5),
        "w_branch_mla": nrm(ks[20], (L, MLA_HEADS * V_HEAD, D), (MLA_HEADS * V_HEAD) ** -0.5),
        "w_out": nrm(ks[21], (L, D, D), D ** -0.5),
        "ffn_norm_g": 1.0 + nrm(ks[22], (L, D), 0.02),
        "moe_w_group": nrm(ks[23], (L, D, N_GROUPS), D ** -0.5),
        "moe_b_group": nrm(ks[24], (L, N_GROUPS), 0.01),
        "moe_w_router": nrm(ks[25], (L, D, N_EXPERTS), D ** -0.5),
        "moe_b_router": nrm(ks[26], (L, N_EXPERTS), 0.01),
        "moe_w_gu": nrm(ks[27], (L, N_EXPERTS, D, 2 * D_EXPERT), D ** -0.5),
        "moe_w_down": nrm(ks[28], (L, N_EXPERTS, D_EXPERT, D), D_EXPERT ** -0.5),
        "final_norm_g": 1.0 + nrm(ks[29], (D,), 0.02),
    }


def reference(x, positions, mix_norm_g, w_in, rw_mu, rw_w0, rw_w_up, rw_a0, rw_a_up, rw_g_up,
              rw_k_k, rw_k_a, rw_r_k, rw_gn_w, rw_gn_b, mla_g_qa, mla_w_q_up, mla_g_kva, mla_w_kv_up,
              w_branch_rw, w_branch_mla, w_out, ffn_norm_g, moe_w_group, moe_b_group, moe_w_router,
              moe_b_router, moe_w_gu, moe_w_down, final_norm_g):
    inv_freq = ROPE_THETA ** (-jnp.arange(0, QK_ROPE, 2, dtype=jnp.float32) / QK_ROPE)
    ang = positions.astype(jnp.float32)[..., None] * inv_freq
    cos, sin = jnp.cos(ang).astype(x.dtype), jnp.sin(ang).astype(x.dtype)

    for l in range(DEPTH):
        h = rmsnorm(x, mix_norm_g[l])
        cols = h @ w_in[l]
        c_rw = cols[..., :RW_COLS]
        c_q = cols[..., RW_COLS:RW_COLS + Q_LORA]
        c_kv = cols[..., RW_COLS + Q_LORA:RW_COLS + Q_LORA + KV_LORA]
        c_kr = cols[..., RW_COLS + Q_LORA + KV_LORA:RW_COLS + MLA_COLS]
        gate_rw = jax.nn.sigmoid(cols[..., RW_COLS + MLA_COLS:RW_COLS + MLA_COLS + D_MODEL])
        gate_mla = jax.nn.sigmoid(cols[..., RW_COLS + MLA_COLS + D_MODEL:])

        y_rw = rwkv7_mix(c_rw, rw_mu[l], rw_w0[l], rw_w_up[l], rw_a0[l], rw_a_up[l], rw_g_up[l],
                         rw_k_k[l], rw_k_a[l], rw_r_k[l], rw_gn_w[l], rw_gn_b[l])
        y_mla = mla_mix(c_q, c_kv, c_kr, cos, sin, mla_g_qa[l], mla_w_q_up[l], mla_g_kva[l], mla_w_kv_up[l])
        merged = gate_rw * (y_rw @ w_branch_rw[l]) + gate_mla * (y_mla @ w_branch_mla[l])
        x = x + merged @ w_out[l]

        h2 = rmsnorm(x, ffn_norm_g[l])
        x = x + hier_moe(h2, moe_w_group[l], moe_b_group[l], moe_w_router[l], moe_b_router[l],
                         moe_w_gu[l], moe_w_down[l])

    return rmsnorm(x, final_norm_g)
```

```cpp
#include <hip/hip_runtime.h>
#include <cstdio>
#include <cstdint>

#ifndef MK_N_LAUNCHES
#define MK_N_LAUNCHES 1
#endif

namespace pg8 {
#define PG8_LAS __attribute__((address_space(3)))
typedef unsigned short bf16_t;
typedef short bf16x8 __attribute__((ext_vector_type(8)));
typedef float f32x4 __attribute__((ext_vector_type(4)));
typedef unsigned u32x4 __attribute__((ext_vector_type(4)));
typedef unsigned u32x2 __attribute__((ext_vector_type(2)));
constexpr int BM = 256, BK = 64, HALF = 128, HTB = HALF * BK * 2  , STAGE_BYTES = 8 * HTB, NXCD = 8, WGM = 8;

__host__ __device__ __forceinline__ int lds_byte(int r, int c) { const int st = (r >> 4) * 2 + (c >> 5), rr = r & 15, cc = c & 31, ob = rr * 64 + cc * 2; return st * 1024 + (ob ^ (((ob >> 9) & 1) << 5)); }
__host__ __device__ __forceinline__ void stage_rc(int b, int& R, int& C) { const int st = b / 1024, sb = b % 1024, swz = sb ^ (((sb >> 9) & 1) << 5); R = (st >> 1) * 16 + swz / 64; C = (st & 1) * 32 + (swz % 64) / 2; }
__host__ __device__ __forceinline__ int perm32(int rho) { const int n = rho >> 4, i = rho & 15; return 8 * (i >> 2) + 4 * n + (i & 3); }

struct Unit { int pm, pn, e, gb; };
struct Gemm { const bf16_t* A; const bf16_t* Bt; int K, lda, ldb; size_t estride; const int* gather; };

struct StaticOrder {
    int nM, nN, nwg, G, c;
    __host__ __device__ __forceinline__ void init(int M, int N, int G_, int c_) { nM = M / BM; nN = N / BM; nwg = nM * nN; G = G_; c = c_; }
    __host__ __device__ __forceinline__ bool next(int i, Unit& u) const {
        const long L = (long)i * G + c; if (L >= nwg) return false;
        int wgid = (int)L; { const int q = nwg / NXCD, r = nwg % NXCD, xcd = wgid % NXCD, off = wgid / NXCD; wgid = (xcd < r ? xcd * (q + 1) : r * (q + 1) + (xcd - r) * q) + off; }
        const int nig = WGM * nN, gid = wgid / nig, fm = gid * WGM, gsz = (nM - fm) < WGM ? (nM - fm) : WGM;
        u.pm = fm + ((wgid % nig) % gsz); u.pn = (wgid % nig) / gsz; u.e = 0; u.gb = 0; return true;
    }
};
struct RangeOrder { int base, cnt, nN; __device__ __forceinline__ bool next(int i, Unit& o) const { if (i >= cnt) return false; const int L = base + i; o.pm = L / nN; o.pn = L % nN; o.e = 0; o.gb = 0; return true; } };
constexpr int MOE_CAP = 32768;
struct MoeOrder {
    const PG8_LAS int* pe; int nN, G, c;
    __device__ __forceinline__ bool next(int i, Unit& u) const {
        const int nblk = pe[31]; const long L = (long)i * G + c; if (L >= (long)nblk * nN) return false;
        const int rb = (int)(L / nN); u.pm = rb; u.pn = (int)(L % nN); int e = 0; while (e < 31 && pe[e] <= rb) ++e; u.e = e; u.gb = e * MOE_CAP + (rb - (e ? pe[e - 1] : 0)) * BM; return true;
    }
};

struct MoeList {
    const PG8_LAS int* pe; int nN, L0, stride, lim;
    __device__ __forceinline__ bool next(int i, Unit& u) const {
        const int L = L0 + i * stride; if (L >= lim) return false;
        const int rb = L / nN; u.pm = rb; u.pn = L % nN; int e = 0; while (e < 31 && pe[e] <= rb) ++e; u.e = e;
        u.gb = e * MOE_CAP + (rb - (e ? pe[e - 1] : 0)) * BM; return true;
    }
};
typedef float f32x2c __attribute__((ext_vector_type(2))); typedef __bf16 bf16x2c __attribute__((ext_vector_type(2)));
__device__ __forceinline__ unsigned cvt_pk_bf16(float lo, float hi) { const f32x2c v = {lo, hi}; return __builtin_bit_cast(unsigned, __builtin_convertvector(v, bf16x2c)); }

typedef double f64x2z __attribute__((ext_vector_type(2)));
__device__ __forceinline__ f32x4 zero4() { double lo, hi; asm volatile("v_mov_b64 %0, 0" : "=v"(lo)); asm volatile("v_mov_b64 %0, 0" : "=v"(hi)); const f64x2z d = {lo, hi}; return __builtin_bit_cast(f32x4, d); }
template <class Epi, class Sched, bool ALIGN_EPI, bool GATHER, bool MIDHOOK = false>
__device__ __forceinline__ void gemm_phase(PG8_LAS unsigned char* lds, const Gemm g, const Sched& S, const Epi& E) {
    const int tid = threadIdx.x, wid = __builtin_amdgcn_readfirstlane(tid >> 6), lane = tid & 63, wr = wid >> 2, wc = wid & 3, fr = lane & 15, fq = lane >> 4;
    const int K = g.K; int nt = K / BK; asm volatile("" : "+s"(nt));
    unsigned voffA[2], voffB[2]; int RA[2], CA[2];
#pragma unroll
    for (int i = 0; i < 2; ++i) { int R, C; stage_rc(tid * 16 + i * 8192, R, C); const int Rb = Epi::PERM ? ((R & ~31) + perm32(R & 31)) : R; RA[i] = R; CA[i] = C;
        voffA[i] = (unsigned)(R * g.lda + C) * 2u; voffB[i] = (unsigned)(Rb * g.ldb + C) * 2u; }
    const size_t kstep = (size_t)(BK * 2);
    const size_t hstepA = GATHER ? (size_t)0 : (size_t)HALF * g.lda * 2, tstepA = GATHER ? (size_t)0 : 2 * hstepA;
    const size_t hstepB = (size_t)HALF * g.ldb * 2, tstepB = 2 * hstepB;
    const unsigned ldsw = (unsigned)wid * 1024u;
    const int aoff = lds_byte(wr * 64 + fr, fq * 8), boff = lds_byte(wc * 32 + fr, fq * 8);
#define PG8_SA(b, h) (((b) * 2 + (h)) * HTB)
#define PG8_SB(b, h) ((4 + (b) * 2 + (h)) * HTB)
#define PG8_STAGE(bufoff, gbase, voff) do { _Pragma("unroll") for (int _i = 0; _i < 2; ++_i) \
        __builtin_amdgcn_global_load_lds((const unsigned*)((const char*)(gbase) + (voff)[_i]), (PG8_LAS unsigned*)(lds + (bufoff) + ldsw + _i * 8192), 16, 0, 0); } while (0)
#define PG8_LDA(dst, b, h) do { _Pragma("unroll") for (int m = 0; m < 4; ++m) _Pragma("unroll") for (int k = 0; k < 2; ++k) dst[m][k] = *(const PG8_LAS bf16x8*)(lds + PG8_SA(b, h) + aoff + m * 2048 + k * 1024); } while (0)
#define PG8_LDB(dst, b, h) do { _Pragma("unroll") for (int n = 0; n < 2; ++n) _Pragma("unroll") for (int k = 0; k < 2; ++k) dst[n][k] = *(const PG8_LAS bf16x8*)(lds + PG8_SB(b, h) + boff + n * 2048 + k * 1024); } while (0)
#define PG8_MMA(ai, bj, At, Bt) do { __builtin_amdgcn_s_setprio(1); _Pragma("unroll") for (int m = 0; m < 4; ++m) _Pragma("unroll") for (int n = 0; n < 2; ++n) _Pragma("unroll") for (int k = 0; k < 2; ++k) \
        acc[ai][bj][m][n] = __builtin_amdgcn_mfma_f32_16x16x32_bf16(Bt[n][k], At[m][k], acc[ai][bj][m][n], 0, 0, 0); __builtin_amdgcn_s_setprio(0); } while (0)
#define PG8_WAIT_V(n) asm volatile("s_waitcnt vmcnt(" #n ")" ::: "memory")
#define PG8_WAIT_L(n) asm volatile("s_waitcnt lgkmcnt(" #n ")" ::: "memory")
#define PG8_BAR __builtin_amdgcn_s_barrier()
#define PG8_SCHED __builtin_amdgcn_sched_barrier(0)
    Unit cur, nxt; int ui = 0;
    if (!S.next(0, cur)) return;
    f32x4 acc[2][2][4][2];
#pragma unroll
    for (int a = 0; a < 2; ++a)
#pragma unroll
        for (int b = 0; b < 2; ++b)
#pragma unroll
            for (int m = 0; m < 4; ++m)
#pragma unroll
                for (int n = 0; n < 2; ++n) acc[a][b][m][n] = zero4();
    bf16x8 At[4][2], B0[2][2], B1[2][2];
    unsigned cA0[2], cA1[2], nA0[2], nA1[2];
#pragma unroll
    for (int i = 0; i < 2; ++i) {
        if constexpr (GATHER) { const int t0 = g.gather[cur.gb + RA[i]], t1 = g.gather[cur.gb + HALF + RA[i]];
            cA0[i] = (unsigned)(t0 * g.lda + CA[i]) * 2u; cA1[i] = (unsigned)(t1 * g.lda + CA[i]) * 2u; }
        else { cA0[i] = voffA[i]; cA1[i] = voffA[i]; }
        nA0[i] = cA0[i]; nA1[i] = cA1[i]; }
    const char* cA = (const char*)g.A + (size_t)cur.pm * tstepA; const char* cB = (const char*)g.Bt + (size_t)cur.e * g.estride * 2 + (size_t)cur.pn * tstepB;
    PG8_STAGE(PG8_SB(0, 0), cB, voffB); PG8_STAGE(PG8_SB(0, 1), cB + hstepB, voffB); PG8_STAGE(PG8_SA(0, 0), cA, cA0); PG8_STAGE(PG8_SA(0, 1), cA + hstepA, cA1);
    if (wr == 1) PG8_BAR;
    PG8_WAIT_V(2); PG8_BAR;
    PG8_STAGE(PG8_SB(1, 0), cB + kstep, voffB); PG8_STAGE(PG8_SA(1, 0), cA + kstep, cA0); PG8_STAGE(PG8_SB(1, 1), cB + hstepB + kstep, voffB);
    PG8_WAIT_V(6); PG8_BAR;
    for (;;) {
        const bool has_next = S.next(ui + 1, nxt);
        const char* nA = has_next ? (const char*)g.A + (size_t)nxt.pm * tstepA : cA; const char* nB = has_next ? (const char*)g.Bt + (size_t)nxt.e * g.estride * 2 + (size_t)nxt.pn * tstepB : cB;
        if constexpr (GATHER) {
            if (has_next) {
#pragma unroll
                for (int i = 0; i < 2; ++i) { const int t0 = g.gather[nxt.gb + RA[i]], t1 = g.gather[nxt.gb + HALF + RA[i]];
                    nA0[i] = (unsigned)(t0 * g.lda + CA[i]) * 2u; nA1[i] = (unsigned)(t1 * g.lda + CA[i]) * 2u; }
            } else {
#pragma unroll
                for (int i = 0; i < 2; ++i) { nA0[i] = cA0[i]; nA1[i] = cA1[i]; }
            }
        }
        for (int t = 0; t < nt; t += 2) {
            const bool last = (t == nt - 2);
            if constexpr (MIDHOOK) { if (2 * t == nt) { int fr_ = lane & 15, fq_ = lane >> 4; asm volatile("" : "+v"(fr_), "+v"(fq_)); E.mid(acc, cur, wr, wc, fr_, fq_); } }
            const char* a1 = cA + (size_t)(t + 1) * kstep;
            const char* a2 = last ? nA : cA + (size_t)(t + 2) * kstep; const char* b2 = last ? nB : cB + (size_t)(t + 2) * kstep;
            const char* a3 = a2 + kstep; const char* b3 = b2 + kstep;
            unsigned sA0[2], sA1[2];
#pragma unroll
            for (int i = 0; i < 2; ++i) { if constexpr (GATHER) { sA0[i] = last ? nA0[i] : cA0[i]; sA1[i] = last ? nA1[i] : cA1[i]; } else { sA0[i] = voffA[i]; sA1[i] = voffA[i]; } }
            PG8_LDB(B0, 0, 0); PG8_LDB(B1, 0, 1); PG8_SCHED; PG8_LDA(At, 0, 0); PG8_STAGE(PG8_SA(1, 1), a1 + hstepA, cA1);
            PG8_WAIT_V(8); PG8_WAIT_L(0); PG8_BAR; PG8_MMA(0, 0, At, B0); PG8_MMA(0, 1, At, B1); PG8_BAR; PG8_SCHED;
            PG8_LDA(At, 0, 1); PG8_STAGE(PG8_SB(0, 0), b2, voffB); PG8_STAGE(PG8_SB(0, 1), b2 + hstepB, voffB); PG8_STAGE(PG8_SA(0, 0), a2, sA0);
            PG8_WAIT_V(8); PG8_WAIT_L(0); PG8_BAR; PG8_MMA(1, 0, At, B0); PG8_MMA(1, 1, At, B1); PG8_BAR; PG8_SCHED;
            PG8_LDB(B0, 1, 0); PG8_LDB(B1, 1, 1); PG8_SCHED; PG8_LDA(At, 1, 0); PG8_STAGE(PG8_SA(0, 1), a2 + hstepA, sA1);
            PG8_WAIT_V(8); PG8_WAIT_L(0); PG8_BAR; PG8_MMA(0, 0, At, B0); PG8_MMA(0, 1, At, B1); PG8_BAR; PG8_SCHED;
            PG8_LDA(At, 1, 1); PG8_STAGE(PG8_SB(1, 0), b3, voffB); PG8_STAGE(PG8_SB(1, 1), b3 + hstepB, voffB); PG8_STAGE(PG8_SA(1, 0), a3, sA0);
            PG8_WAIT_V(8); PG8_WAIT_L(0); PG8_BAR; PG8_MMA(1, 0, At, B0); PG8_MMA(1, 1, At, B1); PG8_BAR; PG8_SCHED;
        }
        if constexpr (ALIGN_EPI) { if (wr == 0) PG8_BAR; }
        { int fr_ = lane & 15, fq_ = lane >> 4; asm volatile("" : "+v"(fr_), "+v"(fq_)); E(acc, cur, wr, wc, fr_, fq_); }
        if (!has_next) break;
#pragma unroll
        for (int a = 0; a < 2; ++a)
#pragma unroll
            for (int b = 0; b < 2; ++b)
#pragma unroll
                for (int m = 0; m < 4; ++m)
#pragma unroll
                    for (int n = 0; n < 2; ++n) acc[a][b][m][n] = zero4();
        cur = nxt; cA = nA; cB = nB; ++ui;
#pragma unroll
        for (int i = 0; i < 2; ++i) { cA0[i] = nA0[i]; cA1[i] = nA1[i]; }
        if constexpr (ALIGN_EPI) { if (wr == 1) PG8_BAR; }
    }
    PG8_WAIT_V(0);
    if constexpr (!ALIGN_EPI) { if (wr == 0) PG8_BAR; }
    PG8_BAR;
#undef PG8_SA
#undef PG8_SB
#undef PG8_STAGE
#undef PG8_LDA
#undef PG8_LDB
#undef PG8_MMA
#undef PG8_WAIT_V
#undef PG8_WAIT_L
#undef PG8_BAR
#undef PG8_SCHED
}
}

constexpr int NWAVES = 8;
constexpr int BATCH = 16, SEQ = 2048, D = 1024, M = BATCH * SEQ;
constexpr int RWD = 512, NH = 8, HD = 64, IN_COLS = 4512;
constexpr int QL = 384, KVL = 256, QKD = 96, QPITCH = NH * QKD;
constexpr int NRWM = 2560;
constexpr int NRKV = 1536, NREST = 1024;
constexpr int R_Q = 256, R_KV = 640, R_KR = 896;
constexpr int C_R = 0, C_K = 512, C_V = 1024, C_WD = 1536, C_AD = 1600, C_GD = 1664, C_Q = 1792, C_KV = 2176, C_KR = 2432;
constexpr int NEXP = 32, DEXP = 256, PMAX = 288 * 256;
constexpr float NORM_EPS = 1e-6f, GN_EPS = 64e-5f;
constexpr float QSCALE = 0.10206207261596577f * 1.4426950408889634f;
constexpr int N_LAUNCHES = MK_N_LAUNCHES;
constexpr int NPH = 14;

constexpr size_t MiB = 1u << 20, KiB = 1u << 10;
constexpr size_t WS_CTL = 0, CTL_ZERO_BYTES = 1 * MiB;
constexpr size_t WS_LWUP = 1 * MiB, WS_LAUP = WS_LWUP + 64 * KiB, WS_LGUP = WS_LAUP + 64 * KiB;
constexpr size_t WS_SQ = WS_LGUP + 128 * KiB, WS_SKV = WS_SQ + 128 * KiB;
constexpr size_t WS_ROUTE = WS_SKV + 128 * KiB;
constexpr size_t WS_GATEW = WS_ROUTE + 512 * KiB;
constexpr size_t WS_POS = WS_GATEW + 256 * KiB;
constexpr size_t WS_TOKBUF = WS_POS + 256 * KiB;
constexpr size_t WS_WBUF = WS_TOKBUF + 288 * KiB;
constexpr size_t WS_RSB = WS_WBUF + 288 * KiB;
static_assert(WS_RSB + 288 * KiB <= 4 * MiB, "small region");
constexpr size_t WS_COS = 4 * MiB, WS_SIN = 6 * MiB;
constexpr size_t WS_WIN = 8 * MiB;
constexpr size_t WS_WQ = 17 * MiB;
constexpr size_t WS_WKN = 18 * MiB, WS_WV = WS_WKN + 256 * KiB;
constexpr size_t WS_WBR = 19 * MiB, WS_WO = 21 * MiB, WS_WR = 23 * MiB;
constexpr size_t WS_XN = 24 * MiB;
constexpr size_t WS_RKV = 88 * MiB;
constexpr size_t WS_REST = 184 * MiB;
constexpr size_t WS_GATEA = 184 * MiB, WS_GATEB = 440 * MiB;
constexpr size_t WS_Q = 248 * MiB, WS_K = 296 * MiB;
constexpr size_t WS_RINV = 360 * MiB;
constexpr size_t WS_TOK2 = 361 * MiB, WS_WB2 = 365 * MiB, WS_RSB2 = 369 * MiB;
constexpr size_t WS_YCAT = 376 * MiB;
constexpr size_t WS_WGU = 88 * MiB, WS_WD = 120 * MiB;
constexpr size_t WS_MERGED = 248 * MiB, WS_ACT = 312 * MiB, WS_LOGITS = 348 * MiB;
constexpr size_t WS_Y = 136 * MiB;
constexpr size_t WS_KROPE = 504 * MiB;
constexpr size_t WS_END = 506 * MiB;
constexpr size_t OUT_DEC = 0, OUT_AA = 64 * MiB, OUT_G = 96 * MiB;
constexpr int CW_CNT = 1024;
constexpr int CW_GQ = 2048;
constexpr int CW_BAR = 4096;
constexpr int CW_PAIR = 8192;

constexpr int RING_BYTES = 131072;
constexpr int MISC_OFF = RING_BYTES;
constexpr int LDS_BYTES = 147456;

#define GAS __attribute__((address_space(1)))
#define LAS __attribute__((address_space(3)))
typedef unsigned short bf16;
typedef unsigned v4u __attribute__((ext_vector_type(4)));
typedef unsigned v2u __attribute__((ext_vector_type(2)));
typedef float f32x4 __attribute__((ext_vector_type(4)));
typedef float f32x2 __attribute__((ext_vector_type(2)));
typedef float f32x16 __attribute__((ext_vector_type(16)));
typedef short bf16x8 __attribute__((ext_vector_type(8)));
typedef short bf16x4 __attribute__((ext_vector_type(4)));
typedef GAS unsigned gu32;
#define RLX_AGENT __ATOMIC_RELAXED, __HIP_MEMORY_SCOPE_AGENT
#define LDS_WAIT() asm volatile("s_waitcnt lgkmcnt(0)" ::: "memory")
#define VM_WAIT() asm volatile("s_waitcnt vmcnt(0)" ::: "memory")
__device__ __forceinline__ unsigned f2bf(float f) { unsigned u = __builtin_bit_cast(unsigned, f); return (u + 0x7fffu + ((u >> 16) & 1u)) >> 16; }
typedef __bf16 bf16x2_t __attribute__((ext_vector_type(2)));
__device__ __forceinline__ unsigned pk2(float lo, float hi) { const f32x2 v = {lo, hi}; return __builtin_bit_cast(unsigned, __builtin_convertvector(v, bf16x2_t)); }
__device__ __forceinline__ float bflo(unsigned w) { return __builtin_bit_cast(float, w << 16); }
__device__ __forceinline__ float bfhi(unsigned w) { return __builtin_bit_cast(float, w & 0xffff0000u); }
__device__ __forceinline__ float sigmoidf_(float x) { return __builtin_amdgcn_rcpf(1.f + __expf(-x)); }
__device__ __forceinline__ float wave_sum(float v) {
#pragma unroll
    for (int o = 1; o < 64; o <<= 1) v += __shfl_xor(v, o);
    return v;
}

#define XB_TMO      128
#define XB_XCNT(j)  (256  + 64 * (j))
#define XB_XSUB(j)  (1280 + 64 * (j))
#define XB_XGEN(j)  (2304 + 64 * (j))
#define XB_TOP      3328
#define XB_TOPGEN   3392
#define XCD_BAR_WORDS 3456
#define XB_SPIN_CAP (1u << 18)

__device__ __forceinline__ unsigned xb_ld(unsigned* p)              { return __hip_atomic_load(p, __ATOMIC_RELAXED, __HIP_MEMORY_SCOPE_AGENT); }
__device__ __forceinline__ unsigned xb_add(unsigned* p, unsigned v) { return __hip_atomic_fetch_add(p, v, __ATOMIC_RELAXED, __HIP_MEMORY_SCOPE_AGENT); }
__device__ __forceinline__ unsigned xb_xcc_id() { return (unsigned)__builtin_amdgcn_s_getreg((3 << 11) | 20) & 0xFu; }
#define XB_SPIN(cond, bar) do { unsigned _sp = 0; while (cond) { __builtin_amdgcn_s_sleep(1); \
    if ((++_sp & 255u) == 0u) { if (xb_ld(&(bar)[XB_TMO])) break; if (_sp > XB_SPIN_CAP) { atomicAdd(&(bar)[XB_TMO], 1u); break; } } } } while (0)

struct XcdBarrier {
    unsigned* bar; unsigned x;
    volatile LAS unsigned* st;
};
__device__ __forceinline__ XcdBarrier xcd_barrier_post(unsigned* bar, volatile LAS unsigned* st) {
    XcdBarrier b; b.bar = bar; b.x = xb_xcc_id(); b.st = st;
    if (threadIdx.x == 0) (void)xb_add(&bar[XB_XCNT(b.x)], 1u);
    return b;
}
__device__ __forceinline__ void xcd_barrier_complete(unsigned* bar, unsigned x, unsigned& nloc, unsigned& nx) {
    const unsigned G = gridDim.x * gridDim.y * gridDim.z;
    unsigned sum, cnt, mine, sp = 0u;
    for (;;) {
        sum = 0u; cnt = 0u; mine = 0u;
#pragma unroll
        for (unsigned j = 0; j < 16; ++j) { const unsigned c = xb_ld(&bar[XB_XCNT(j)]); sum += c; cnt += (c > 0u) ? 1u : 0u; mine = (j == x) ? c : mine; }
        if (sum == G) break;
        __builtin_amdgcn_s_sleep(1);
        if ((++sp & 255u) == 0u) { if (xb_ld(&bar[XB_TMO])) break; if (sp > XB_SPIN_CAP) { atomicAdd(&bar[XB_TMO], 1u); break; } }
    }
    nloc = mine > 0u ? mine : 1u; nx = cnt > 0u ? cnt : 1u;
}
__device__ __forceinline__ void xcd_barrier(const XcdBarrier& b) {
    asm volatile("s_waitcnt vmcnt(0)" ::: "memory");
    __syncthreads();
    if (threadIdx.x == 0) {
        unsigned* bar = b.bar;
        __builtin_amdgcn_s_waitcnt(0);
        unsigned nloc = b.st[0], nx = b.st[1];
        if (nloc == 0u) { xcd_barrier_complete(bar, b.x, nloc, nx); b.st[0] = nloc; b.st[1] = nx; }
        const unsigned old = xb_add(&bar[XB_XSUB(b.x)], 1u);
        const unsigned gen = old / nloc;
        if (old + 1u == (gen + 1u) * nloc) {
            __builtin_amdgcn_fence(__ATOMIC_RELEASE, "agent");
            asm volatile("s_waitcnt vmcnt(0)" ::: "memory");
            const unsigned og = xb_add(&bar[XB_TOP], 1u);
            const unsigned tg = og / nx;
            if (og + 1u == (tg + 1u) * nx) xb_add(&bar[XB_TOPGEN], 1u);
            else XB_SPIN(xb_ld(&bar[XB_TOPGEN]) == tg, bar);
            __builtin_amdgcn_fence(__ATOMIC_ACQUIRE, "agent");
            xb_add(&bar[XB_XGEN(b.x)], 1u);
            asm volatile("s_waitcnt vmcnt(0)" ::: "memory");
        } else {
            XB_SPIN(xb_ld(&bar[XB_XGEN(b.x)]) == gen, bar);
            __builtin_amdgcn_fence(__ATOMIC_ACQUIRE, "agent");
            asm volatile("s_waitcnt vmcnt(0)" ::: "memory");
        }
    }
    __syncthreads();
}

__device__ __forceinline__ void pair_barrier(unsigned* cnt, unsigned* bar) {
    asm volatile("s_waitcnt vmcnt(0)" ::: "memory");
    __syncthreads();
    if (threadIdx.x == 0) {
        __builtin_amdgcn_fence(__ATOMIC_RELEASE, "agent");
        asm volatile("s_waitcnt vmcnt(0)" ::: "memory");
        (void)xb_add(cnt, 1u);
        XB_SPIN(xb_ld(cnt) < 2u, bar);
        __builtin_amdgcn_fence(__ATOMIC_ACQUIRE, "agent");
        asm volatile("s_waitcnt vmcnt(0)" ::: "memory");
    }
    __syncthreads();
}

struct Frame {
    LAS unsigned char* lds;
    gu32* ctl;
    int tid, lane, wave;
    int vcu, G;
    const void* const* in;
    float* out; unsigned char* ws;
};

using pg8::Unit; using pg8::cvt_pk_bf16; using pg8::MOE_CAP;
constexpr int HALF = pg8::HALF, BM = pg8::BM;
__device__ __forceinline__ unsigned gate8_pack4(float a, float b, float c, float d) {
    unsigned w = 0u;
    w = __builtin_amdgcn_cvt_pk_u8_f32(__builtin_fmaf(a, 256.f, -0.5f), 0u, w); w = __builtin_amdgcn_cvt_pk_u8_f32(__builtin_fmaf(b, 256.f, -0.5f), 1u, w);
    w = __builtin_amdgcn_cvt_pk_u8_f32(__builtin_fmaf(c, 256.f, -0.5f), 2u, w); w = __builtin_amdgcn_cvt_pk_u8_f32(__builtin_fmaf(d, 256.f, -0.5f), 3u, w);
    return w;
}
__device__ __forceinline__ float gate8_q(unsigned w, int j) { return (float)((w >> (8 * j)) & 0xffu) + 0.5f; }
struct EpiGate8 {
    static constexpr bool PERM = true;
    unsigned char* G8;
    __device__ __forceinline__ void operator()(const f32x4 (&acc)[2][2][4][2], const Unit& u, int wr, int wc, int fr, int fq) const {
        const int row0 = u.pm * BM + wr * 64 + fr, col0 = u.pn * BM + wc * 32 + 8 * fq;
#pragma unroll
        for (int ai = 0; ai < 2; ++ai)
#pragma unroll
            for (int m = 0; m < 4; ++m) { unsigned char* rowp = G8 + (size_t)(row0 + ai * HALF + m * 16) * D + col0;
#pragma unroll
                for (int bj = 0; bj < 2; ++bj) { const f32x4 v0 = acc[ai][bj][m][0], v1 = acc[ai][bj][m][1];
                    v2u w; w.x = gate8_pack4(sigmoidf_(v0[0]), sigmoidf_(v0[1]), sigmoidf_(v0[2]), sigmoidf_(v0[3])); w.y = gate8_pack4(sigmoidf_(v1[0]), sigmoidf_(v1[1]), sigmoidf_(v1[2]), sigmoidf_(v1[3]));
                    *(v2u*)(rowp + bj * HALF) = w; } }
    }
};
struct EpiP1 {
    static constexpr bool PERM = true;
    unsigned char* GB; bf16* RKV; bf16* REST;
    __device__ __forceinline__ void operator()(const f32x4 (&acc)[2][2][4][2], const Unit& u, int wr, int wc, int fr, int fq) const {
        const int row0 = u.pm * BM + wr * 64 + fr;
        if (u.pn < 4) {
            const int col0 = u.pn * BM + wc * 32 + 8 * fq;
#pragma unroll
            for (int ai = 0; ai < 2; ++ai)
#pragma unroll
                for (int m = 0; m < 4; ++m) { unsigned char* rowp = GB + (size_t)(row0 + ai * HALF + m * 16) * D + col0;
#pragma unroll
                    for (int bj = 0; bj < 2; ++bj) { const f32x4 v0 = acc[ai][bj][m][0], v1 = acc[ai][bj][m][1];
                        v2u w; w.x = gate8_pack4(sigmoidf_(v0[0]), sigmoidf_(v0[1]), sigmoidf_(v0[2]), sigmoidf_(v0[3])); w.y = gate8_pack4(sigmoidf_(v1[0]), sigmoidf_(v1[1]), sigmoidf_(v1[2]), sigmoidf_(v1[3]));
                        *(v2u*)(rowp + bj * HALF) = w; } }
            return;
        }
        bf16* O = REST; int ldc = NREST, tb = 10;
        if (u.pn < 10) { O = RKV; ldc = NRKV; tb = 4; }
        const int col0 = (u.pn - tb) * BM + wc * 32 + 8 * fq;
#pragma unroll
        for (int ai = 0; ai < 2; ++ai)
#pragma unroll
            for (int m = 0; m < 4; ++m) { bf16* rowp = O + (size_t)(row0 + ai * HALF + m * 16) * ldc + col0;
#pragma unroll
                for (int bj = 0; bj < 2; ++bj) { const f32x4 v0 = acc[ai][bj][m][0], v1 = acc[ai][bj][m][1];
                    v4u w; w.x = cvt_pk_bf16(v0[0], v0[1]); w.y = cvt_pk_bf16(v0[2], v0[3]); w.z = cvt_pk_bf16(v1[0], v1[1]); w.w = cvt_pk_bf16(v1[2], v1[3]);
                    *(v4u*)(rowp + bj * HALF) = w; } }
    }
};
struct EpiMerge2 {
    static constexpr bool PERM = true;
    const unsigned char* GA; const unsigned char* GB; bf16* Mg;
    __device__ __forceinline__ void mid(f32x4 (&acc)[2][2][4][2], const Unit& u, int wr, int wc, int fr, int fq) const {
        const int row0 = u.pm * BM + wr * 64 + fr, col0 = u.pn * BM + wc * 32 + 8 * fq;
#pragma unroll
        for (int ai = 0; ai < 2; ++ai) { v2u ga[4][2], gb[4][2];
#pragma unroll
            for (int m = 0; m < 4; ++m)
#pragma unroll
                for (int bj = 0; bj < 2; ++bj) { const size_t off = (size_t)(row0 + ai * HALF + m * 16) * D + col0 + bj * HALF; ga[m][bj] = *(const v2u*)(GA + off); gb[m][bj] = *(const v2u*)(GB + off); }
#pragma unroll
            for (int m = 0; m < 4; ++m)
#pragma unroll
                for (int bj = 0; bj < 2; ++bj) { const unsigned aw[2] = {ga[m][bj].x, ga[m][bj].y}, bw[2] = {gb[m][bj].x, gb[m][bj].y};
#pragma unroll
                    for (int n = 0; n < 2; ++n)
#pragma unroll
                        for (int j = 0; j < 4; ++j) acc[ai][bj][m][n][j] *= gate8_q(aw[n], j) * __builtin_amdgcn_rcpf(gate8_q(bw[n], j)); }
            asm volatile("" ::: "memory"); }
    }
    __device__ __forceinline__ void operator()(const f32x4 (&acc)[2][2][4][2], const Unit& u, int wr, int wc, int fr, int fq) const {
        const int row0 = u.pm * BM + wr * 64 + fr, col0 = u.pn * BM + wc * 32 + 8 * fq;
        v2u gv[2][4][2];
#pragma unroll
        for (int ai = 0; ai < 2; ++ai)
#pragma unroll
            for (int m = 0; m < 4; ++m)
#pragma unroll
                for (int bj = 0; bj < 2; ++bj) gv[ai][m][bj] = *(const v2u*)(GB + (size_t)(row0 + ai * HALF + m * 16) * D + col0 + bj * HALF);
#pragma unroll
        for (int ai = 0; ai < 2; ++ai)
#pragma unroll
            for (int m = 0; m < 4; ++m) { const size_t off = (size_t)(row0 + ai * HALF + m * 16) * D + col0;
#pragma unroll
                for (int bj = 0; bj < 2; ++bj) { const f32x4 a0 = acc[ai][bj][m][0], a1 = acc[ai][bj][m][1]; const v2u g = gv[ai][m][bj]; constexpr float k = 1.f / 256.f;
                    v4u w; w.x = cvt_pk_bf16(gate8_q(g.x, 0) * k * a0[0], gate8_q(g.x, 1) * k * a0[1]); w.y = cvt_pk_bf16(gate8_q(g.x, 2) * k * a0[2], gate8_q(g.x, 3) * k * a0[3]);
                    w.z = cvt_pk_bf16(gate8_q(g.y, 0) * k * a1[0], gate8_q(g.y, 1) * k * a1[1]); w.w = cvt_pk_bf16(gate8_q(g.y, 2) * k * a1[2], gate8_q(g.y, 3) * k * a1[3]);
                    *(v4u*)(Mg + off + bj * HALF) = w; } }
    }
};
struct EpiXmid {
    static constexpr bool PERM = true;
    const float* RINV; bf16* XB; float* SS;
    __device__ __forceinline__ void operator()(const f32x4 (&acc)[2][2][4][2], const Unit& u, int wr, int wc, int fr, int fq) const {
        const int row0 = u.pm * BM + wr * 64 + fr, col0 = u.pn * BM + wc * 32 + 8 * fq;
#pragma unroll
        for (int ai = 0; ai < 2; ++ai) { v4u xv[4][2]; float ri[4];
#pragma unroll
            for (int m = 0; m < 4; ++m) { ri[m] = RINV[row0 + ai * HALF + m * 16];
#pragma unroll
                for (int bj = 0; bj < 2; ++bj) xv[m][bj] = *(const v4u*)(XB + (size_t)(row0 + ai * HALF + m * 16) * D + col0 + bj * HALF); }
#pragma unroll
            for (int m = 0; m < 4; ++m) { const int row = row0 + ai * HALF + m * 16; const size_t off = (size_t)row * D + col0; float ss = 0.f; const float r = ri[m];
#pragma unroll
                for (int bj = 0; bj < 2; ++bj) { const v4u x = xv[m][bj];
                    const f32x4 v0 = (f32x4){bflo(x.x), bfhi(x.x), bflo(x.y), bfhi(x.y)} * r + acc[ai][bj][m][0], v1 = (f32x4){bflo(x.z), bfhi(x.z), bflo(x.w), bfhi(x.w)} * r + acc[ai][bj][m][1];
                    ss += ((v0[0] * v0[0] + v0[1] * v0[1]) + (v0[2] * v0[2] + v0[3] * v0[3])) + ((v1[0] * v1[0] + v1[1] * v1[1]) + (v1[2] * v1[2] + v1[3] * v1[3]));
                    v4u w; w.x = cvt_pk_bf16(v0[0], v0[1]); w.y = cvt_pk_bf16(v0[2], v0[3]); w.z = cvt_pk_bf16(v1[0], v1[1]); w.w = cvt_pk_bf16(v1[2], v1[3]);
                    *(v4u*)(XB + off + bj * HALF) = w; }
                ss += __shfl_xor(ss, 16); ss += __shfl_xor(ss, 32);
                if (fq == 0) atomicAdd(SS + row, ss); } }
    }
};
struct EpiQ {
    static constexpr bool PERM = false;
    bf16* Q; const float* sq; const float* cs; const float* sn;
    __device__ __forceinline__ void operator()(const f32x4 (&acc)[2][2][4][2], const Unit& u, int wr, int wc, int fr, int fq) const {
        const int row0 = u.pm * BM + wr * 64 + fr;
#pragma unroll
        for (int ai = 0; ai < 2; ++ai) { float sv_[4]; f32x4 cv[4], sv[4];
#pragma unroll
            for (int m = 0; m < 4; ++m) { const int row = row0 + ai * HALF + m * 16; sv_[m] = sq[row]; cv[m] = *(const f32x4*)(cs + (size_t)row * 16 + 4 * fq); sv[m] = *(const f32x4*)(sn + (size_t)row * 16 + 4 * fq); }
#pragma unroll
            for (int m = 0; m < 4; ++m) { const int row = row0 + ai * HALF + m * 16; const float s = sv_[m] * QSCALE;
#pragma unroll
                for (int bj = 0; bj < 2; ++bj) { const int g32 = u.pn * 8 + bj * 4 + wc; const int col = g32 * 32 + 4 * fq;
                    f32x4 t1 = acc[ai][bj][m][0] * s, t2 = acc[ai][bj][m][1] * s;
                    if (g32 % 3 == 2) { const f32x4 o1 = t1 * cv[m] - t2 * sv[m], o2 = t2 * cv[m] + t1 * sv[m]; t1 = o1; t2 = o2; }
                    v2u w1, w2; w1.x = cvt_pk_bf16(t1[0], t1[1]); w1.y = cvt_pk_bf16(t1[2], t1[3]); w2.x = cvt_pk_bf16(t2[0], t2[1]); w2.y = cvt_pk_bf16(t2[2], t2[3]);
                    *(v2u*)(Q + (size_t)row * QPITCH + col) = w1; *(v2u*)(Q + (size_t)row * QPITCH + col + 16) = w2; } } }
    }
};
struct EpiKn {
    static constexpr bool PERM = true;
    bf16* Kb; const float* skv;
    __device__ __forceinline__ void operator()(const f32x4 (&acc)[2][2][4][2], const Unit& u, int wr, int wc, int fr, int fq) const {
        const int row0 = u.pm * BM + wr * 64 + fr; float sc_[2][4];
#pragma unroll
        for (int ai = 0; ai < 2; ++ai)
#pragma unroll
            for (int m = 0; m < 4; ++m) sc_[ai][m] = skv[row0 + ai * HALF + m * 16];
#pragma unroll
        for (int ai = 0; ai < 2; ++ai)
#pragma unroll
            for (int m = 0; m < 4; ++m) { const int row = row0 + ai * HALF + m * 16; const float s = sc_[ai][m];
#pragma unroll
                for (int bj = 0; bj < 2; ++bj) { const int c = u.pn * BM + bj * HALF + wc * 32 + 8 * fq;
                    const f32x4 v0 = acc[ai][bj][m][0] * s, v1 = acc[ai][bj][m][1] * s;
                    v4u w; w.x = cvt_pk_bf16(v0[0], v0[1]); w.y = cvt_pk_bf16(v0[2], v0[3]); w.z = cvt_pk_bf16(v1[0], v1[1]); w.w = cvt_pk_bf16(v1[2], v1[3]);
                    *(v4u*)(Kb + (size_t)row * 1024 + c) = w; } }
    }
};
struct EpiLogits {
    static constexpr bool PERM = false;
    float* L; const float* SS;
    __device__ __forceinline__ void operator()(const f32x4 (&acc)[2][2][4][2], const Unit& u, int wr, int wc, int fr, int fq) const {
        if (u.pn != 0 || wc >= 2) return;
        const int row0 = u.pm * BM + wr * 64 + fr; float sc_[2][4];
#pragma unroll
        for (int ai = 0; ai < 2; ++ai)
#pragma unroll
            for (int m = 0; m < 4; ++m) sc_[ai][m] = 1.f / sqrtf(SS[row0 + ai * HALF + m * 16] * (1.f / D) + NORM_EPS);
#pragma unroll
        for (int ai = 0; ai < 2; ++ai)
#pragma unroll
            for (int m = 0; m < 4; ++m)
#pragma unroll
                for (int n = 0; n < 2; ++n) { const int row = row0 + ai * HALF + m * 16; const float rs = sc_[ai][m]; *(f32x4*)(L + (size_t)row * 64 + wc * 32 + n * 16 + 4 * fq) = acc[ai][0][m][n] * rs; }
    }
};
struct EpiSwiglu {
    static constexpr bool PERM = true;
    bf16* ACT; const float* rsb;
    __device__ __forceinline__ void operator()(const f32x4 (&acc)[2][2][4][2], const Unit& u, int wr, int wc, int fr, int fq) const {
        const int row0 = u.pm * BM + wr * 64 + fr, col0 = u.pn * HALF + wc * 32 + 8 * fq; float sc_[2][4];
#pragma unroll
        for (int ai = 0; ai < 2; ++ai)
#pragma unroll
            for (int m = 0; m < 4; ++m) sc_[ai][m] = rsb[u.gb + wr * 64 + fr + ai * HALF + m * 16];
#pragma unroll
        for (int ai = 0; ai < 2; ++ai)
#pragma unroll
            for (int m = 0; m < 4; ++m) { float r[8]; const float rs = sc_[ai][m];
#pragma unroll
                for (int n = 0; n < 2; ++n)
#pragma unroll
                    for (int j = 0; j < 4; ++j) { const float gt = acc[ai][0][m][n][j] * rs, up = acc[ai][1][m][n][j] * rs; r[n * 4 + j] = gt * sigmoidf_(gt) * up; }
                v4u w; w.x = cvt_pk_bf16(r[0], r[1]); w.y = cvt_pk_bf16(r[2], r[3]); w.z = cvt_pk_bf16(r[4], r[5]); w.w = cvt_pk_bf16(r[6], r[7]);
                *(v4u*)(ACT + (size_t)(row0 + ai * HALF + m * 16) * DEXP + col0) = w; }
    }
};
struct EpiDown {
    static constexpr bool PERM = true;
    bf16* Y; const float* wbuf;
    __device__ __forceinline__ void operator()(const f32x4 (&acc)[2][2][4][2], const Unit& u, int wr, int wc, int fr, int fq) const {
        const int row0 = u.pm * BM + wr * 64 + fr, col0 = u.pn * BM + wc * 32 + 8 * fq; float sc_[2][4];
#pragma unroll
        for (int ai = 0; ai < 2; ++ai)
#pragma unroll
            for (int m = 0; m < 4; ++m) sc_[ai][m] = wbuf[u.gb + wr * 64 + fr + ai * HALF + m * 16];
#pragma unroll
        for (int ai = 0; ai < 2; ++ai)
#pragma unroll
            for (int m = 0; m < 4; ++m) { const int row = row0 + ai * HALF + m * 16; const float s = sc_[ai][m];
#pragma unroll
                for (int bj = 0; bj < 2; ++bj) { const f32x4 v0 = acc[ai][bj][m][0] * s, v1 = acc[ai][bj][m][1] * s;
                    v4u w; w.x = cvt_pk_bf16(v0[0], v0[1]); w.y = cvt_pk_bf16(v0[2], v0[3]); w.z = cvt_pk_bf16(v1[0], v1[1]); w.w = cvt_pk_bf16(v1[2], v1[3]);
                    *(v4u*)(Y + (size_t)row * D + col0 + bj * HALF) = w; } }
    }
};

__device__ __forceinline__ void p0_transpose_item(const float* W, int ldw, int k0, int n0, bf16* WT, int ldt, int dst_row0, const float* kscale, LAS float* scr, int lane) {
    f32x4 ld[8];
#pragma unroll
    for (int i = 0; i < 8; ++i) ld[i] = *(const f32x4*)(W + (size_t)(k0 + (lane >> 3) + 8 * i) * ldw + n0 + 4 * (lane & 7));
    float ksv[8];
#pragma unroll
    for (int i = 0; i < 8; ++i) ksv[i] = kscale ? kscale[k0 + (lane >> 3) + 8 * i] : 1.f;
    asm volatile("" : "+v"(ksv[0]), "+v"(ksv[1]), "+v"(ksv[2]), "+v"(ksv[3]), "+v"(ksv[4]), "+v"(ksv[5]), "+v"(ksv[6]), "+v"(ksv[7]));
#pragma unroll
    for (int i = 0; i < 8; ++i) { const int kk = (lane >> 3) + 8 * i; const float s = ksv[i]; LAS float* d = scr + kk * 33 + 4 * (lane & 7); d[0] = ld[i].x * s; d[1] = ld[i].y * s; d[2] = ld[i].z * s; d[3] = ld[i].w * s; }
    LDS_WAIT(); asm volatile("" ::: "memory");
    const int c = lane & 7;
#pragma unroll
    for (int j = 0; j < 4; ++j) { const int n = (lane >> 3) + 8 * j; const LAS float* s = scr + (8 * c) * 33 + n;
        v4u o; o.x = pk2(s[0 * 33], s[1 * 33]); o.y = pk2(s[2 * 33], s[3 * 33]); o.z = pk2(s[4 * 33], s[5 * 33]); o.w = pk2(s[6 * 33], s[7 * 33]);
        *(v4u*)(WT + (size_t)(dst_row0 + n) * ldt + k0 + 8 * c) = o; }
    LDS_WAIT(); asm volatile("" ::: "memory");
}
struct P0In { const float *ffn_g, *x, *mix_g, *w_in, *w_up, *a_up, *g_up, *g_qa, *w_q_up, *g_kva, *w_kv_up, *w_br, *w_bm, *w_out, *w_group, *w_router, *w_gu, *w_down; const int* pos; };
__device__ __forceinline__ void p0_prologue(const Frame& F, const P0In& I) {
    unsigned char* ws = F.ws;
    LAS float* scr = (LAS float*)(F.lds + F.wave * 16384);
    const int gw = F.vcu * NWAVES + F.wave, NGW = F.G * NWAVES, lane = F.lane;
    constexpr int I_IN = 16 * 141, I_Q = 6 * 24, I_KV = 4 * 32, I_BR = 8 * 32, I_O = 16 * 32, I_LW = 16, I_LG = 32;
    constexpr int NITEMS = I_IN + I_Q + I_KV + 2 * I_BR + I_O + 2 * I_LW + I_LG;
    for (int it = gw; it < NITEMS; it += NGW) {
        int r = it;
        if (r < I_IN) { const int kb = r / 141, nb = r % 141, n0 = nb * 32;
            const int dst = n0 < 1792 ? 2048 + n0 : (n0 < 2464 ? 3840 + (n0 - 1792) : (n0 < 3488 ? n0 - 2464 : 1024 + (n0 - 3488)));
            p0_transpose_item(I.w_in, IN_COLS, kb * 64, n0, (bf16*)(ws + WS_WIN), D, dst, I.mix_g, scr, lane); continue; } r -= I_IN;
        if (r < I_Q) { const int kb = r / 24, nb = r % 24; p0_transpose_item(I.w_q_up, 768, kb * 64, nb * 32, (bf16*)(ws + WS_WQ), QL, nb * 32, I.g_qa, scr, lane); continue; } r -= I_Q;
        if (r < I_KV) { const int kb = r / 32, nb = r % 32, n0 = nb * 32, h = n0 >> 7, j = n0 & 127; const int dst = j < 64 ? h * 64 + j : 512 + h * 64 + (j - 64);
            p0_transpose_item(I.w_kv_up, 1024, kb * 64, n0, (bf16*)(ws + WS_WKN), KVL, dst, I.g_kva, scr, lane); continue; } r -= I_KV;
        if (r < I_BR) { const int kb = r / 32, nb = r % 32; p0_transpose_item(I.w_br, D, kb * 64, nb * 32, (bf16*)(ws + WS_WBR), D, nb * 32, nullptr, scr, lane); continue; } r -= I_BR;
        if (r < I_BR) { const int kb = r / 32, nb = r % 32; p0_transpose_item(I.w_bm, D, kb * 64, nb * 32, (bf16*)(ws + WS_WBR) + RWD, D, nb * 32, nullptr, scr, lane); continue; } r -= I_BR;
        if (r < I_O) { const int kb = r / 32, nb = r % 32; p0_transpose_item(I.w_out, D, kb * 64, nb * 32, (bf16*)(ws + WS_WO), D, nb * 32, nullptr, scr, lane); continue; } r -= I_O;
        if (r < I_LW) { p0_transpose_item(I.w_up, RWD, 0, r * 32, (bf16*)(ws + WS_LWUP), 64, r * 32, nullptr, scr, lane); continue; } r -= I_LW;
        if (r < I_LW) { p0_transpose_item(I.a_up, RWD, 0, r * 32, (bf16*)(ws + WS_LAUP), 64, r * 32, nullptr, scr, lane); continue; } r -= I_LW;
        { const int kb = r / 16, nb = r % 16; p0_transpose_item(I.g_up, RWD, kb * 64, nb * 32, (bf16*)(ws + WS_LGUP), 128, nb * 32, nullptr, scr, lane); }
    }
    const int gt = F.vcu * (NWAVES * 64) + F.tid, NGT = F.G * NWAVES * 64;
    { bf16* WR = (bf16*)(ws + WS_WR);
      for (int i = gt; i < 256 * D; i += NGT) { const int j = i >> 10, k = i & 1023; float v = 0.f; if (j < 4) v = I.w_group[k * 4 + j]; else if (j < 36) v = I.w_router[k * 32 + (j - 4)]; WR[i] = (bf16)f2bf(v * I.ffn_g[k]); }
      bf16* WP = (bf16*)(ws + WS_WIN) + (size_t)IN_COLS * D;
      for (int i = gt; i < 96 * D; i += NGT) WP[i] = 0; }
    { float* CS = (float*)(ws + WS_COS); float* SN = (float*)(ws + WS_SIN);
      for (int i = gt; i < M * 16; i += NGT) { const int m = i >> 4, j = i & 15;
          const float inv_freq = exp2f(-(float)j * (13.287712379549449f / 16.f));
          const float ang = (float)I.pos[m] * inv_freq;
          const double rev = (double)ang * 0.15915494309189535; const double fr = rev - __builtin_rint(rev);
          CS[i] = __builtin_amdgcn_cosf((float)fr); SN[i] = __builtin_amdgcn_sinf((float)fr); } }
    { v4u* TB = (v4u*)(ws + WS_TOK2); for (int i = gt; i < 32 * MOE_CAP / 4; i += NGT) TB[i] = (v4u){0u, 0u, 0u, 0u}; }
    { bf16* XN = (bf16*)(ws + WS_XN); float* RINV = (float*)(ws + WS_RINV);
      for (int m = gw; m < M; m += NGW) {
          const f32x4* xr = (const f32x4*)(I.x + (size_t)m * D) + lane;
          f32x4 v[4]; float s = 0.f;
#pragma unroll
          for (int j = 0; j < 4; ++j) { v[j] = xr[64 * j]; s += (v[j].x * v[j].x + v[j].y * v[j].y) + (v[j].z * v[j].z + v[j].w * v[j].w); }
          const float rq = sqrtf(wave_sum(s) * (1.f / D) + NORM_EPS), rs = 1.f / rq; if (lane == 0) RINV[m] = rq;
          unsigned long long* o8 = (unsigned long long*)(XN + (size_t)m * D) + lane;
#pragma unroll
          for (int j = 0; j < 4; ++j) o8[64 * j] = (unsigned long long)pk2(v[j].x * rs, v[j].y * rs) | ((unsigned long long)pk2(v[j].z * rs, v[j].w * rs) << 32);
      } }
}

__device__ __forceinline__ float dpp_add_xor1(float v) { return v + __builtin_bit_cast(float, __builtin_amdgcn_update_dpp(0, __builtin_bit_cast(int, v), 0xB1, 0xF, 0xF, true)); }
__device__ __forceinline__ float dpp_add_xor2(float v) { return v + __builtin_bit_cast(float, __builtin_amdgcn_update_dpp(0, __builtin_bit_cast(int, v), 0x4E, 0xF, 0xF, true)); }
__device__ __forceinline__ float dpp_add_hmir(float v) { return v + __builtin_bit_cast(float, __builtin_amdgcn_update_dpp(0, __builtin_bit_cast(int, v), 0x141, 0xF, 0xF, true)); }
__device__ __forceinline__ float red8(float v) { return dpp_add_hmir(dpp_add_xor2(dpp_add_xor1(v))); }
__device__ __forceinline__ float dpp_add_mir(float v) { return v + __builtin_bit_cast(float, __builtin_amdgcn_update_dpp(0, __builtin_bit_cast(int, v), 0x140, 0xF, 0xF, true)); }
__device__ __forceinline__ float red16(float v) { return dpp_add_mir(red8(v)); }
struct P2In { const float *mu, *w0, *a0; };
template <int KD> __device__ __forceinline__ void lora_load(bf16x8 (&wf)[KD / 32][4], const bf16* Wt, int wave, int lane) {
    const int i = lane & 15, q = lane >> 4;
#pragma unroll
    for (int ks = 0; ks < KD / 32; ++ks)
#pragma unroll
        for (int cb = 0; cb < 4; ++cb) wf[ks][cb] = *(const bf16x8*)(Wt + (size_t)(64 * wave + 16 * cb + i) * KD + 32 * ks + 8 * q);
}
template <int KD> __device__ __forceinline__ void lora_mma(f32x4 (&acc)[4][4], const bf16x8 (&wf)[KD / 32][4], const LAS bf16* act, int apitch, int wave, int lane) {
    const int i = lane & 15, q = lane >> 4;
#pragma unroll
    for (int cb = 0; cb < 4; ++cb)
#pragma unroll
        for (int tb = 0; tb < 4; ++tb) acc[cb][tb] = (f32x4){0.f, 0.f, 0.f, 0.f};
#pragma unroll
    for (int ks = 0; ks < KD / 32; ++ks) {
        bf16x8 bfr[4];
#pragma unroll
        for (int tb = 0; tb < 4; ++tb) bfr[tb] = *(const LAS bf16x8*)(act + (16 * tb + i) * apitch + 32 * ks + 8 * q);
#pragma unroll
        for (int cb = 0; cb < 4; ++cb) { const bf16x8 afr = wf[ks][cb];
#pragma unroll
            for (int tb = 0; tb < 4; ++tb) acc[cb][tb] = __builtin_amdgcn_mfma_f32_16x16x32_bf16(afr, bfr[tb], acc[cb][tb], 0, 0, 0); }
    }
}
__device__ __forceinline__ void p2_prep(const Frame& F, const P2In& I) {
    unsigned char* ws = F.ws;
    const bf16* REST = (const bf16*)(ws + WS_REST);
    float* DEC = (float*)((unsigned char*)F.out + OUT_DEC); bf16* AA = (bf16*)((unsigned char*)F.out + OUT_AA); bf16* GG = (bf16*)((unsigned char*)F.out + OUT_G);
    LAS bf16* Aw = (LAS bf16*)(F.lds); LAS bf16* Aa = (LAS bf16*)(F.lds + 9216); LAS bf16* Ag = (LAS bf16*)(F.lds + 18432);
    const int lane = F.lane, wave = F.wave, i16 = lane & 15, q = lane >> 4;
    bf16x8 wfw[2][4], wfa[2][4];
    lora_load<64>(wfw, (const bf16*)(ws + WS_LWUP), wave, lane); lora_load<64>(wfa, (const bf16*)(ws + WS_LAUP), wave, lane);
    for (int tile = F.vcu; tile < M / 64; tile += F.G) {
        const int m0 = tile * 64;
        for (int c = F.tid; c < 2048; c += NWAVES * 64) { const int tok = c >> 5, ch = (c & 31) * 8; const int m = m0 + tok;
            const bf16* cur = REST + (size_t)m * NREST + ch;
            const v4u cv = *(const v4u*)cur; v4u pv = (v4u){0u, 0u, 0u, 0u}; if ((m & (SEQ - 1)) != 0) pv = *(const v4u*)(cur - NREST);
            const f32x4 mu0 = *(const f32x4*)(I.mu + C_WD + ch), mu1 = *(const f32x4*)(I.mu + C_WD + ch + 4);
            float z[8]; const unsigned cw[4] = {cv.x, cv.y, cv.z, cv.w}, pw[4] = {pv.x, pv.y, pv.z, pv.w}; const float muv[8] = {mu0.x, mu0.y, mu0.z, mu0.w, mu1.x, mu1.y, mu1.z, mu1.w};
#pragma unroll
            for (int j = 0; j < 4; ++j) { const float c0 = bflo(cw[j]), c1 = bfhi(cw[j]), p0 = bflo(pw[j]), p1 = bfhi(pw[j]); z[2 * j] = c0 + (p0 - c0) * muv[2 * j]; z[2 * j + 1] = c1 + (p1 - c1) * muv[2 * j + 1]; }
            LAS bf16* dst;
            if (ch < 64) {
#pragma unroll
                for (int j = 0; j < 8; ++j) { const float e = __expf(2.f * z[j]); z[j] = 1.f - 2.f * __builtin_amdgcn_rcpf(e + 1.f); }
                dst = Aw + tok * 72 + ch;
            } else if (ch < 128) dst = Aa + tok * 72 + (ch - 64);
            else {
#pragma unroll
                for (int j = 0; j < 8; ++j) z[j] = sigmoidf_(z[j]);
                dst = Ag + tok * 136 + (ch - 128);
            }
            v4u o; o.x = pk2(z[0], z[1]); o.y = pk2(z[2], z[3]); o.z = pk2(z[4], z[5]); o.w = pk2(z[6], z[7]);
            *(LAS v4u*)dst = o;
        }
        __syncthreads();
        f32x4 acc[4][4];
        f32x4 w0v[4];
#pragma unroll
        for (int cb = 0; cb < 4; ++cb) w0v[cb] = *(const f32x4*)(I.w0 + 64 * wave + 16 * cb + 4 * q);
        asm volatile("" : "+v"(w0v[0]), "+v"(w0v[1]), "+v"(w0v[2]), "+v"(w0v[3]));
        lora_mma<64>(acc, wfw, Aw, 72, wave, lane);
#pragma unroll
        for (int cb = 0; cb < 4; ++cb) { const int ch = 64 * wave + 16 * cb + 4 * q; const f32x4 w0 = w0v[cb];
#pragma unroll
            for (int tb = 0; tb < 4; ++tb) { const int m = m0 + 16 * tb + i16; f32x4 o;
#pragma unroll
                for (int j = 0; j < 4; ++j) { float x = -0.6065306597126334f * sigmoidf_(w0[j] + acc[cb][tb][j]);
                    x += __builtin_bit_cast(float, __builtin_amdgcn_update_dpp(0, __builtin_bit_cast(int, x), 0x111, 0xF, 0xF, true)); x += __builtin_bit_cast(float, __builtin_amdgcn_update_dpp(0, __builtin_bit_cast(int, x), 0x112, 0xF, 0xF, true));
                    x += __builtin_bit_cast(float, __builtin_amdgcn_update_dpp(0, __builtin_bit_cast(int, x), 0x114, 0xF, 0xF, true)); x += __builtin_bit_cast(float, __builtin_amdgcn_update_dpp(0, __builtin_bit_cast(int, x), 0x118, 0xF, 0xF, true));
                    o[j] = x; }
                *(f32x4*)(DEC + (size_t)m * RWD + ch) = o; } }
        f32x4 a0v[4];
#pragma unroll
        for (int cb = 0; cb < 4; ++cb) a0v[cb] = *(const f32x4*)(I.a0 + 64 * wave + 16 * cb + 4 * q);
        asm volatile("" : "+v"(a0v[0]), "+v"(a0v[1]), "+v"(a0v[2]), "+v"(a0v[3]));
        lora_mma<64>(acc, wfa, Aa, 72, wave, lane);
#pragma unroll
        for (int cb = 0; cb < 4; ++cb) { const int ch = 64 * wave + 16 * cb + 4 * q; const f32x4 a0 = a0v[cb];
#pragma unroll
            for (int tb = 0; tb < 4; ++tb) { const int m = m0 + 16 * tb + i16; v2u o;
                o.x = pk2(sigmoidf_(a0[0] + acc[cb][tb][0]), sigmoidf_(a0[1] + acc[cb][tb][1])); o.y = pk2(sigmoidf_(a0[2] + acc[cb][tb][2]), sigmoidf_(a0[3] + acc[cb][tb][3]));
                *(v2u*)(AA + (size_t)m * RWD + ch) = o; } }
        {
          const bf16* Wg = (const bf16*)(ws + WS_LGUP);
#pragma unroll
          for (int kh = 0; kh < 2; ++kh) { bf16x8 wg[2][4];
#pragma unroll
              for (int ks = 0; ks < 2; ++ks)
#pragma unroll
                  for (int cb = 0; cb < 4; ++cb) wg[ks][cb] = *(const bf16x8*)(Wg + (size_t)(64 * wave + 16 * cb + i16) * 128 + 64 * kh + 32 * ks + 8 * q);
              asm volatile("" : "+v"(wg[0][0]), "+v"(wg[0][1]), "+v"(wg[0][2]), "+v"(wg[0][3]), "+v"(wg[1][0]), "+v"(wg[1][1]), "+v"(wg[1][2]), "+v"(wg[1][3]));
#pragma unroll
              for (int ks = 0; ks < 2; ++ks) { bf16x8 bfr[4];
#pragma unroll
                  for (int tb = 0; tb < 4; ++tb) bfr[tb] = *(const LAS bf16x8*)(Ag + (16 * tb + i16) * 136 + 64 * kh + 32 * ks + 8 * q);
#pragma unroll
                  for (int cb = 0; cb < 4; ++cb)
#pragma unroll
                      for (int tb = 0; tb < 4; ++tb) acc[cb][tb] = __builtin_amdgcn_mfma_f32_16x16x32_bf16(wg[ks][cb], bfr[tb], (kh == 0 && ks == 0) ? (f32x4){0.f, 0.f, 0.f, 0.f} : acc[cb][tb], 0, 0, 0); } } }
#pragma unroll
        for (int cb = 0; cb < 4; ++cb) { const int ch = 64 * wave + 16 * cb + 4 * q;
#pragma unroll
            for (int tb = 0; tb < 4; ++tb) { const int m = m0 + 16 * tb + i16; v2u o; o.x = pk2(acc[cb][tb][0], acc[cb][tb][1]); o.y = pk2(acc[cb][tb][2], acc[cb][tb][3]);
                *(v2u*)(GG + (size_t)m * RWD + ch) = o; } }
        __syncthreads();
    }
    float* SQ = (float*)(ws + WS_SQ); float* SKV = (float*)(ws + WS_SKV); const float* CS = (const float*)(ws + WS_COS); const float* SN = (const float*)(ws + WS_SIN);
    bf16* KR = (bf16*)(ws + WS_KROPE);
    const int gw = F.vcu * NWAVES + wave, NGW = F.G * NWAVES, g4 = lane >> 4, l16 = lane & 15;
    for (int mb = gw * 4; mb < M; mb += NGW * 4) {
        const int m = mb + g4; const bf16* rowp = REST + (size_t)m * NREST;
        v4u q[3], k[2];
#pragma unroll
        for (int j = 0; j < 3; ++j) q[j] = *(const v4u*)(rowp + R_Q + (l16 + 16 * j) * 8);
#pragma unroll
        for (int j = 0; j < 2; ++j) k[j] = *(const v4u*)(rowp + R_KV + (l16 + 16 * j) * 8);
        const float t1 = bflo((unsigned)rowp[R_KR + l16]), t2 = bflo((unsigned)rowp[R_KR + 16 + l16]); const float c = CS[(size_t)m * 16 + l16], sn = SN[(size_t)m * 16 + l16];
        float s1 = 0.f, s2 = 0.f;
#pragma unroll
        for (int j = 0; j < 3; ++j) { const unsigned w[4] = {q[j].x, q[j].y, q[j].z, q[j].w};
#pragma unroll
            for (int e = 0; e < 4; ++e) { const float a = bflo(w[e]), b = bfhi(w[e]); s1 += a * a + b * b; } }
#pragma unroll
        for (int j = 0; j < 2; ++j) { const unsigned w[4] = {k[j].x, k[j].y, k[j].z, k[j].w};
#pragma unroll
            for (int e = 0; e < 4; ++e) { const float a = bflo(w[e]), b = bfhi(w[e]); s2 += a * a + b * b; } }
        s1 = red16(s1); s2 = red16(s2);
        if (l16 == 0) { SQ[m] = 1.f / sqrtf(s1 * (1.f / QL) + NORM_EPS); SKV[m] = 1.f / sqrtf(s2 * (1.f / KVL) + NORM_EPS); }
        KR[(size_t)m * 32 + l16] = (bf16)f2bf(t1 * c - t2 * sn); KR[(size_t)m * 32 + 16 + l16] = (bf16)f2bf(t2 * c + t1 * sn);
    }
}

struct ScanIn { const float *mu, *k_k, *k_a, *r_k, *gn_w, *gn_b; };
typedef short bf16x4s __attribute__((ext_vector_type(4)));
constexpr int SC_T = 32;
constexpr int TP = 44;
constexpr int L_KT = 0, L_RT = 4608, L_KH = 9216, L_NBH = 13824, L_KHT = 18432, L_NBHT = L_KHT + 64 * TP * 2, L_VV = L_NBHT + 64 * TP * 2, L_M1T = L_VV + 64 * TP * 2, L_M2T = L_M1T + 1536, L_N2T = L_M2T + 1536, L_NT = L_N2T + 1536, L_GC = L_NT + 2048,
              L_XT = L_GC + 512, L_ZTT = L_XT + 16896, L_QT = L_ZTT + 128 * TP * 2, L_ZK = L_QT + 4608, L_S0 = L_ZK + 4608, L_Y1T = L_S0 + 18432, L_LW = L_Y1T;
constexpr int L_KHT2 = L_Y1T + 32 * 68 * 4, L_GC2 = L_KHT2 + 3 * 64 * TP * 2;
constexpr int L_ZK2 = L_M1T;
constexpr int L_Y1T2 = L_S0 + 9216;
constexpr int L_ZTT2 = MISC_OFF + 1024;
static_assert(L_NBHT == L_KHT + 64 * TP * 2 && L_VV == L_NBHT + 64 * TP * 2 && L_GC2 + 512 <= RING_BYTES && L_M1T + 4608 <= L_NT && 32 * 68 * 4 <= 9216 && L_ZTT2 + 128 * TP * 2 <= LDS_BYTES, "scan LDS map");
__device__ __forceinline__ f32x4 mfma16(bf16x4s a, bf16x4s b, f32x4 c) { return __builtin_amdgcn_mfma_f32_16x16x16bf16_1k(a, b, c, 0, 0, 0); }
__device__ __forceinline__ f32x4 mfma32(bf16x8 a, bf16x8 b, f32x4 c) { return __builtin_amdgcn_mfma_f32_16x16x32_bf16(a, b, c, 0, 0, 0); }
__device__ __forceinline__ void scan_phase(const Frame& F, const ScanIn& I, int bh) {
    unsigned char* ws = F.ws; LAS unsigned char* lds = F.lds;
    const int b = bh >> 3, h = bh & 7, tid = F.tid, lane = F.lane, wave = F.wave, l15_ = lane & 15, q4_ = lane >> 4;
    const bf16* RKV = (const bf16*)(ws + WS_RKV);
    const float* DEC = (const float*)((unsigned char*)F.out + OUT_DEC); const bf16* AA = (const bf16*)((unsigned char*)F.out + OUT_AA); const bf16* GG = (const bf16*)((unsigned char*)F.out + OUT_G);
    bf16* YRW = (bf16*)(ws + WS_YCAT);
    const int tt = tid >> 4, c4 = (tid & 15) * 4, hc = h * HD + c4;
    f32x4 mu_r = *(const f32x4*)(I.mu + C_R + hc), mu_k = *(const f32x4*)(I.mu + C_K + hc), mu_v = *(const f32x4*)(I.mu + C_V + hc);
    f32x4 kk_k = *(const f32x4*)(I.k_k + hc), kk_a = *(const f32x4*)(I.k_a + hc), rr_k = *(const f32x4*)(I.r_k + hc);
    f32x4 gnw = *(const f32x4*)(I.gn_w + hc), gnb = *(const f32x4*)(I.gn_b + hc);
    asm volatile("" : "+v"(mu_r), "+v"(mu_k), "+v"(mu_v), "+v"(kk_k), "+v"(kk_a), "+v"(rr_k), "+v"(gnw), "+v"(gnb));
    for (int i = tid; i < 2 * 64 * 72 / 2; i += NWAVES * 64) ((LAS unsigned*)(lds + L_S0))[i] = 0u;
    int pp = 0;
    f32x4 Sacc[4];
#pragma unroll
    for (int kb = 0; kb < 4; ++kb) Sacc[kb] = (f32x4){0.f, 0.f, 0.f, 0.f};
    v2u rc, rp, kc, kpv, vc, vp, av; f32x4 cum4, cprev4;
#define SC_BAR() asm volatile("s_waitcnt lgkmcnt(0)\n\ts_barrier" ::: "memory")
#define SC_LOAD(c) do { const int m_ = b * SEQ + (c) * SC_T + tt; const bf16* rowp_ = RKV + (size_t)m_ * NRKV + hc; \
        rc = *(const v2u*)(rowp_ + C_R); kc = *(const v2u*)(rowp_ + C_K); vc = *(const v2u*)(rowp_ + C_V); \
        if ((m_ & (SEQ - 1)) != 0) { rp = *(const v2u*)(rowp_ + C_R - NRKV); kpv = *(const v2u*)(rowp_ + C_K - NRKV); vp = *(const v2u*)(rowp_ + C_V - NRKV); } \
        else { rp = (v2u){0u, 0u}; kpv = rp; vp = rp; } \
        av = *(const v2u*)(AA + (size_t)m_ * RWD + hc); cum4 = *(const f32x4*)(DEC + (size_t)m_ * RWD + hc); \
        if ((tt & 15) != 0) cprev4 = *(const f32x4*)(DEC + (size_t)(m_ - 1) * RWD + hc); else cprev4 = (f32x4){0.f, 0.f, 0.f, 0.f}; } while (0)
#define SC_MIX(cw, pw, muv) ((f32x4){ bflo(cw.x) + (bflo(pw.x) - bflo(cw.x)) * muv.x, bfhi(cw.x) + (bfhi(pw.x) - bfhi(cw.x)) * muv.y, bflo(cw.y) + (bflo(pw.y) - bflo(cw.y)) * muv.z, bfhi(cw.y) + (bfhi(pw.y) - bfhi(cw.y)) * muv.w })
#define ST4(off_, row_, pitch_, v_) do { v2u w_; w_.x = pk2((v_).x, (v_).y); w_.y = pk2((v_).z, (v_).w); *(LAS v2u*)(lds + (off_) + ((row_) * (pitch_) + c4) * 2) = w_; } while (0)
#define STT(off_, v_) do { LAS bf16* p_ = (LAS bf16*)(lds + (off_)) + c4 * TP + tt; const unsigned w0_ = pk2((v_).x, (v_).y), w1_ = pk2((v_).z, (v_).w); p_[0] = (bf16)w0_; p_[TP] = (bf16)(w0_ >> 16); p_[2 * TP] = (bf16)w1_; p_[3 * TP] = (bf16)(w1_ >> 16); } while (0)
    constexpr int NCH = SEQ / SC_T;
    f32x4 zv = (f32x4){0.f, 0.f, 0.f, 0.f}; float bon = 0.f;
    v2u gwn = (v2u){0u, 0u};
    f32x4 zv1 = zv, zv2 = zv; float bon1 = 0.f, bon2 = 0.f;
    SC_LOAD(0);
    for (int c = 0; c <= NCH + 1; ++c) {
        int l15 = l15_, q4 = q4_, tsel = tid; asm volatile("" : "+v"(l15), "+v"(q4), "+v"(tsel));
        const int par = c & 1;
        const int oKT_c = par * (L_KHT2 - L_KHT), oGC_c = par * (L_GC2 - L_GC), oZT_c = par * (L_ZTT2 - L_ZTT), oZK_c = par * (L_ZK2 - L_ZK), oY_c = par * (L_Y1T2 - L_Y1T);
        const int oKT_p = (L_KHT2 - L_KHT) - oKT_c, oGC_p = (L_GC2 - L_GC) - oGC_c, oZT_p = (L_ZTT2 - L_ZTT) - oZT_c, oZK_p = (L_ZK2 - L_ZK) - oZK_c, oY_p = (L_Y1T2 - L_Y1T) - oY_c;
        zv2 = zv1; bon2 = bon1; zv1 = zv; bon1 = bon;
        f32x4 g4 = (f32x4){bflo(gwn.x), bfhi(gwn.x), bflo(gwn.y), bfhi(gwn.y)};
        asm volatile("" : "+v"(g4));
        if (c < NCH) {
        const f32x4 zr = SC_MIX(rc, rp, mu_r), zk = SC_MIX(kc, kpv, mu_k); zv = SC_MIX(vc, vp, mu_v);
        const f32x4 a_ = (f32x4){bflo(av.x), bfhi(av.x), bflo(av.y), bfhi(av.y)};
        f32x4 kap = zk * kk_k; const float ss = red16((kap.x * kap.x + kap.y * kap.y) + (kap.z * kap.z + kap.w * kap.w));
        kap = kap * __builtin_amdgcn_rsqf(fmaxf(ss, 1e-24f));
        const f32x4 k2 = zk * (1.f + (a_ - 1.f) * kk_a); const f32x4 bb = kap * a_;
        const f32x4 t_ = zr * k2 * rr_k; bon = red16((t_.x + t_.y) + (t_.z + t_.w));
        const f32x4 cum = cum4, cumprev = cprev4;
        f32x4 ep, ec, en;
#pragma unroll
        for (int j = 0; j < 4; ++j) { ep[j] = __expf(cumprev[j]); ec[j] = __expf(cum[j]); en[j] = __expf(-cum[j]); }
        const f32x4 kt = kap * ep, rt = zr * ec, kh = k2 * en, nbh = bb * (-en);
        ST4(L_KT, tt, 72, kt); ST4(L_RT, tt, 72, rt); ST4(L_KH, tt, 72, kh); ST4(L_NBH, tt, 72, nbh);
        STT(L_KHT + oKT_c, kh); STT(L_NBHT + oKT_c, nbh); STT(L_VV + oKT_c, zv);
        *(LAS f32x4*)(lds + L_XT + (tt * 132 + 64 + c4) * 4) = kt;
        if ((tt & 15) == 15) *(LAS f32x4*)(lds + L_GC + oGC_c + ((tt >> 4) * 64 + c4) * 4) = ec;
        if (c + 1 < NCH) SC_LOAD(c + 1);
        }
        if (c >= 2) { const int cc_ = c - 2;
        { const int m = b * SEQ + cc_ * SC_T + tt;
          const f32x4 y4 = *(const LAS f32x4*)(lds + L_Y1T + oY_c + (tt * 68 + c4) * 4);
          const float mean = red16((y4.x + y4.y) + (y4.z + y4.w)) * (1.f / 64.f);
          const f32x4 d = y4 - mean; const float var = red16((d.x * d.x + d.y * d.y) + (d.z * d.z + d.w * d.w)) * (1.f / 64.f);
          const float rs = __builtin_amdgcn_rsqf(var + GN_EPS);
          const f32x4 o = (d * rs * gnw + gnb + zv2 * bon2) * g4;
          v2u ow; ow.x = pk2(o.x, o.y); ow.y = pk2(o.z, o.w);
          *(v2u*)(YRW + (size_t)m * D + hc) = ow; }
        }
        if (c >= 1 && c <= NCH) gwn = *(const v2u*)(GG + (size_t)(b * SEQ + (c - 1) * SC_T + tt) * RWD + hc);
        SC_BAR();
        if (c < NCH) {
        { const int c2 = wave >> 2, vb = wave & 3;
          bf16x8 fkh[2], fkt[2], fnb[2];
#pragma unroll
          for (int ks = 0; ks < 2; ++ks) { const int o = ((16 * c2 + l15) * 72 + 32 * ks + 8 * q4) * 2; fkh[ks] = *(const LAS bf16x8*)(lds + L_KH + o); fkt[ks] = *(const LAS bf16x8*)(lds + L_KT + o); fnb[ks] = *(const LAS bf16x8*)(lds + L_NBH + o); }
          const bf16x4s fvv = *(const LAS bf16x4s*)(lds + L_VV + oKT_c + ((16 * vb + l15) * TP + 16 * c2 + 4 * q4) * 2);
          f32x4 m1 = (f32x4){0.f, 0.f, 0.f, 0.f}, nn = (f32x4){0.f, 0.f, 0.f, 0.f};
          m1 = mfma32(fkh[0], fkt[0], m1); m1 = mfma32(fkh[1], fkt[1], m1);
          if (vb == 0) { nn = mfma32(fnb[0], fkt[0], nn); nn = mfma32(fnb[1], fkt[1], nn); }
#pragma unroll
          for (int r = 0; r < 4; ++r) { if (!(4 * q4 + r < l15)) { m1[r] = 0.f; nn[r] = 0.f; } }
          v2u mw; mw.x = pk2(m1[0], m1[1]); mw.y = pk2(m1[2], m1[3]);
          const f32x4 x1 = mfma16(__builtin_bit_cast(bf16x4s, mw), fvv, (f32x4){0.f, 0.f, 0.f, 0.f});
          if (vb == 0) {
#pragma unroll
              for (int r = 0; r < 4; ++r) *(LAS float*)(lds + L_NT + ((c2 * 16 + 4 * q4 + r) * 16 + l15) * 4) = nn[r]; }
#pragma unroll
          for (int r = 0; r < 4; ++r) *(LAS float*)(lds + L_XT + ((16 * c2 + 4 * q4 + r) * 132 + 16 * vb + l15) * 4) = x1[r]; }
        }
        SC_BAR();
        if (tid < 256) { if (c < NCH) { const int c2 = tsel >> 7, col = tsel & 127; float z[16];
#pragma unroll
            for (int t = 0; t < 16; ++t) z[t] = *(const LAS float*)(lds + L_XT + ((16 * c2 + t) * 132 + col) * 4);
#pragma unroll
            for (int i = 0; i < 15; ++i) {
#pragma unroll
                for (int t4 = (i + 1) / 4; t4 < 4; ++t4) { const f32x4 nv = *(const LAS f32x4*)(lds + L_NT + ((c2 * 16 + i) * 16 + 4 * t4) * 4);
#pragma unroll
                    for (int j = 0; j < 4; ++j) if (4 * t4 + j > i) z[4 * t4 + j] += nv[j] * z[i]; } }
            v4u w0, w1; w0.x = pk2(z[0], z[1]); w0.y = pk2(z[2], z[3]); w0.z = pk2(z[4], z[5]); w0.w = pk2(z[6], z[7]); w1.x = pk2(z[8], z[9]); w1.y = pk2(z[10], z[11]); w1.z = pk2(z[12], z[13]); w1.w = pk2(z[14], z[15]);
            LAS v2u* zp = (LAS v2u*)(lds + L_ZTT + oZT_c + (col * TP + 16 * c2) * 2); zp[0] = (v2u){w0.x, w0.y}; zp[1] = (v2u){w0.z, w0.w}; zp[2] = (v2u){w1.x, w1.y}; zp[3] = (v2u){w1.z, w1.w};
            if (col >= 64) { LAS bf16* zk = (LAS bf16*)(lds + L_ZK + oZK_c) + (16 * c2) * 72 + (col - 64); const unsigned ww[8] = {w0.x, w0.y, w0.z, w0.w, w1.x, w1.y, w1.z, w1.w};
#pragma unroll
                for (int j = 0; j < 8; ++j) { zk[(2 * j) * 72] = (bf16)ww[j]; zk[(2 * j + 1) * 72] = (bf16)(ww[j] >> 16); } } } }
        else if (c > 0 && c <= NCH) {
            { const int vb = wave & 3;
#pragma unroll
              for (int c2 = 0; c2 < 2; ++c2) {
                  bf16x8 fq[2], fz[2], fs[2];
#pragma unroll
                  for (int ks = 0; ks < 2; ++ks) { const int o = ((16 * c2 + l15) * 72 + 32 * ks + 8 * q4) * 2; fq[ks] = *(const LAS bf16x8*)(lds + L_QT + o); fz[ks] = *(const LAS bf16x8*)(lds + L_ZK + oZK_p + o);
                      fs[ks] = *(const LAS bf16x8*)(lds + L_S0 + ((16 * vb + l15) * 72 + 32 * ks + 8 * q4) * 2); }
                  f32x4 yacc;
#pragma unroll
                  for (int r = 0; r < 4; ++r) yacc[r] = *(const LAS float*)(lds + L_Y1T + oY_p + ((16 * c2 + 4 * q4 + r) * 68 + 16 * vb + l15) * 4);
                  const v2u zvw = *(const LAS v2u*)(lds + L_ZTT + oZT_p + ((16 * vb + l15) * TP + 16 * c2 + 4 * q4) * 2);
                  const bf16x4s fv = *(const LAS bf16x4s*)(lds + L_VV + oKT_p + ((16 * vb + l15) * TP + 16 * c2 + 4 * q4) * 2);
                  bf16x4s fn[4], fk[4]; float gc[4];
#pragma unroll
                  for (int kb = 0; kb < 4; ++kb) { fn[kb] = *(const LAS bf16x4s*)(lds + L_NBHT + oKT_p + ((16 * kb + l15) * TP + 16 * c2 + 4 * q4) * 2); fk[kb] = *(const LAS bf16x4s*)(lds + L_KHT + oKT_p + ((16 * kb + l15) * TP + 16 * c2 + 4 * q4) * 2);
                      gc[kb] = *(const LAS float*)(lds + L_GC + oGC_p + (c2 * 64 + 16 * kb + l15) * 4); }
                  yacc = mfma32(fq[0], fs[0], yacc); yacc = mfma32(fq[1], fs[1], yacc);
                  f32x4 acc = (f32x4){bflo(zvw.x), bfhi(zvw.x), bflo(zvw.y), bfhi(zvw.y)};
                  acc = mfma32(fz[0], fs[0], acc); acc = mfma32(fz[1], fs[1], acc);
#pragma unroll
                  for (int r = 0; r < 4; ++r) *(LAS float*)(lds + L_Y1T + oY_p + ((16 * c2 + 4 * q4 + r) * 68 + 16 * vb + l15) * 4) = yacc[r];
                  v2u uw; uw.x = pk2(acc[0], acc[1]); uw.y = pk2(acc[2], acc[3]); const bf16x4s fu = __builtin_bit_cast(bf16x4s, uw);
#pragma unroll
                  for (int kb = 0; kb < 4; ++kb) { Sacc[kb] = mfma16(fu, fn[kb], Sacc[kb]); Sacc[kb] = mfma16(fv, fk[kb], Sacc[kb]); }
#pragma unroll
                  for (int kb = 0; kb < 4; ++kb) { Sacc[kb] = Sacc[kb] * gc[kb]; const unsigned w0_ = pk2(Sacc[kb][0], Sacc[kb][1]), w1_ = pk2(Sacc[kb][2], Sacc[kb][3]);
                      LAS bf16* sp = (LAS bf16*)(lds + L_S0) + (16 * vb + 4 * q4) * 72 + 16 * kb + l15;
                      sp[0] = (bf16)w0_; sp[72] = (bf16)(w0_ >> 16); sp[144] = (bf16)w1_; sp[216] = (bf16)(w1_ >> 16); }
                  LDS_WAIT();
              } }
        }
        SC_BAR();
        if (c < NCH) {
        { const int c2 = wave >> 2;
          bf16x8 fkh[2], frt[2], fnb[2];
#pragma unroll
          for (int ks = 0; ks < 2; ++ks) { const int o = ((16 * c2 + l15) * 72 + 32 * ks + 8 * q4) * 2; fkh[ks] = *(const LAS bf16x8*)(lds + L_KH + o); frt[ks] = *(const LAS bf16x8*)(lds + L_RT + o); fnb[ks] = *(const LAS bf16x8*)(lds + L_NBH + o); }
          bf16x4s fb[2], fb2[2]; float rtv[2][4];
#pragma unroll
          for (int j = 0; j < 2; ++j) { const int nb = (2 * wave + j) & 7;
              fb[j] = *(const LAS bf16x4s*)(lds + L_ZTT + oZT_c + ((16 * nb + l15) * TP + 16 * c2 + 4 * q4) * 2); fb2[j] = *(const LAS bf16x4s*)(lds + L_VV + oKT_c + ((16 * (nb & 3) + l15) * TP + 16 * c2 + 4 * q4) * 2);
#pragma unroll
              for (int r = 0; r < 4; ++r) rtv[j][r] = bflo((unsigned)*(const LAS bf16*)(lds + L_RT + ((16 * c2 + 4 * q4 + r) * 72 + 16 * (nb & 3) + l15) * 2)); }
          f32x4 m2 = (f32x4){0.f, 0.f, 0.f, 0.f}, n2 = (f32x4){0.f, 0.f, 0.f, 0.f};
          n2 = mfma32(fnb[0], frt[0], n2); n2 = mfma32(fnb[1], frt[1], n2);
          const bool needm2 = ((2 * wave) & 7) < 4;
          if (needm2) { m2 = mfma32(fkh[0], frt[0], m2); m2 = mfma32(fkh[1], frt[1], m2); }
#pragma unroll
          for (int r = 0; r < 4; ++r) { if (!(4 * q4 + r <= l15)) { m2[r] = 0.f; n2[r] = 0.f; } }
          v2u w2; w2.x = pk2(n2[0], n2[1]); w2.y = pk2(n2[2], n2[3]); const bf16x4s fn2 = __builtin_bit_cast(bf16x4s, w2);
          v2u w3; w3.x = pk2(m2[0], m2[1]); w3.y = pk2(m2[2], m2[3]); const bf16x4s fm2 = __builtin_bit_cast(bf16x4s, w3);
          f32x4 acc[2];
#pragma unroll
          for (int j = 0; j < 2; ++j) { acc[j] = mfma16(fn2, fb[j], (f32x4){0.f, 0.f, 0.f, 0.f}); if (needm2) acc[j] = mfma16(fm2, fb2[j], acc[j]); }
#pragma unroll
          for (int j = 0; j < 2; ++j) { const int nb = (2 * wave + j) & 7;
              if (nb < 4) {
#pragma unroll
                  for (int r = 0; r < 4; ++r) *(LAS float*)(lds + L_Y1T + oY_c + ((16 * c2 + 4 * q4 + r) * 68 + 16 * nb + l15) * 4) = acc[j][r]; }
              else { const unsigned w0_ = pk2(acc[j][0] + rtv[j][0], acc[j][1] + rtv[j][1]), w1_ = pk2(acc[j][2] + rtv[j][2], acc[j][3] + rtv[j][3]);
                  LAS bf16* qp = (LAS bf16*)(lds + L_QT) + (16 * c2 + 4 * q4) * 72 + 16 * (nb - 4) + l15;
                  qp[0] = (bf16)w0_; qp[72] = (bf16)(w0_ >> 16); qp[144] = (bf16)w1_; qp[216] = (bf16)(w1_ >> 16); } } }
        }
        SC_BAR();
    }
    __syncthreads();
#undef SC_BAR
#undef SC_LOAD
#undef SC_MIX
#undef ST4
#undef STT
}

constexpr int AT_SLOT = 12288, AT_K = 0, AT_V = 3 * AT_SLOT, AT_WS = 6 * AT_SLOT, AT_OST = AT_WS + 8 * 256, AT_END = AT_OST + 8 * 4096;
static_assert(AT_END <= 131072, "attention LDS");
constexpr int ATP = 1024;
constexpr int AT_THR = 8;
typedef LAS const char* at_lptr; typedef short at_v4i16 __attribute__((ext_vector_type(4)));
__device__ __forceinline__ int at_crow(int r, int hi) { return (r & 3) + 8 * (r >> 2) + 4 * hi; }
__device__ __forceinline__ void at_glds16(const void* sbase, unsigned voff, unsigned lds_dst) { unsigned keep;
    asm volatile("s_mov_b32 %0, m0\n\ts_mov_b32 m0, %3\n\ts_nop 0\n\tglobal_load_lds_dwordx4 %1, %2\n\ts_mov_b32 m0, %0" : "=&s"(keep) : "v"(voff), "s"(sbase), "s"(lds_dst) : "memory"); }
__device__ __forceinline__ void at_kload2(bf16x8* kf, at_lptr kp, int j) { kf[2 * j] = *(const LAS bf16x8*)(kp + j * 2048); kf[2 * j + 1] = *(const LAS bf16x8*)(kp + j * 2048 + 512); }
__device__ __forceinline__ bf16x4 at_vtr(at_lptr p) { return __builtin_bit_cast(bf16x4, __builtin_amdgcn_ds_read_tr16_b64_v4i16((LAS at_v4i16*)p)); }
__device__ __forceinline__ void at_cmask(f32x16& p0, f32x16& p1, int jb, int qrel, int hi) {
    const int kb = 64 * jb + 4 * hi;
#pragma unroll
    for (int r = 0; r < 16; ++r) { const int kv = kb + (r & 3) + 8 * (r >> 2); if (kv > qrel) p0[r] = -INFINITY; if (kv + 32 > qrel) p1[r] = -INFINITY; }
}
#define AT_MFMA(a, b, c) __builtin_amdgcn_mfma_f32_32x32x16_bf16(a, b, c, 0, 0, 0)
#define AT_SBAR() __builtin_amdgcn_sched_barrier(0)
#define AT_PIN(x) asm volatile("" : "+v"(x))
#define AT_WAIT_BAR(N) asm volatile("s_waitcnt vmcnt(" #N ") lgkmcnt(0)\n\ts_barrier" ::: "memory")
#define AT_MX3(a, b, c) __builtin_fmaxf(__builtin_fmaxf((a), (b)), (c))
__device__ __forceinline__ float at_rowmax(const f32x16& p0, const f32x16& p1) {
    float a = AT_MX3(p0[0], p0[1], p1[0]), b = AT_MX3(p0[2], p0[3], p1[1]); a = AT_MX3(a, p1[2], p1[3]);
#pragma unroll
    for (int r = 4; r < 16; r += 4) { a = AT_MX3(a, p0[r], p0[r + 1]); b = AT_MX3(b, p0[r + 2], p0[r + 3]); a = AT_MX3(a, p1[r], p1[r + 1]); b = AT_MX3(b, p1[r + 2], p1[r + 3]); }
    float m = __builtin_fmaxf(a, b); auto rr = __builtin_amdgcn_permlane32_swap(__float_as_uint(m), __float_as_uint(m), false, false);
    return __builtin_fmaxf(__uint_as_float(rr[0]), __uint_as_float(rr[1]));
}
__device__ __forceinline__ void attn_unit(const Frame& F, int b, int h, int qb) {
    unsigned char* ws = F.ws;
    const int lane = F.lane, r32 = lane & 31, hi = lane >> 5, wid = F.wave;
    const size_t rowbase = (size_t)b * SEQ; const int q0 = qb * 256;
    const bf16* Qw = (const bf16*)(ws + WS_Q) + (rowbase + q0 + wid * 32) * QPITCH + h * QKD;
    const char* Kh = (const char*)((const bf16*)(ws + WS_K) + rowbase * ATP + h * HD);
    const char* Krp = (const char*)((const bf16*)(ws + WS_KROPE) + rowbase * 32);
    LAS unsigned char* shm = F.lds;
    const unsigned lds0 = (unsigned)(size_t)shm;
    LAS float* wsf = (LAS float*)(shm + AT_WS) + wid * 64;
    const unsigned koff = (unsigned)(lane * ATP) * 2u;
    const unsigned voff = (unsigned)(512 + (16 * (wid & 3) + (lane >> 2)) * ATP + (wid >> 2) * 32 + (lane & 3) * 8) * 2u;
    const unsigned kdst = lds0 + AT_K + wid * 1024, kdst2 = lds0 + AT_K + (8 + (wid & 3)) * 1024, vdst = lds0 + AT_V + wid * 1024;
#define DMA_K(t, slot) do { at_glds16(Kh + wid * 16 + (size_t)(t) * (64 * ATP * 2), koff, (unsigned)__builtin_amdgcn_readfirstlane(kdst + (slot))); unsigned k2_; asm volatile("v_lshrrev_b32 %0, 5, %1" : "=v"(k2_) : "v"(koff)); at_glds16(Krp + (wid & 3) * 16 + (size_t)(t) * (64 * 32 * 2), k2_, (unsigned)__builtin_amdgcn_readfirstlane(kdst2 + (slot))); } while (0)
#define DMA_V(t, slot) at_glds16(Kh + (size_t)(t) * (64 * ATP * 2), voff, (unsigned)__builtin_amdgcn_readfirstlane(vdst + (slot)))
    const at_lptr shm3 = (at_lptr)shm; const at_lptr kp0 = shm3 + AT_K + hi * 1024 + r32 * 16;
    const at_lptr vp0 = shm3 + AT_V + ((lane >> 4) & 1) * 32 + (lane & 3) * 8 + (4 * hi + ((lane & 15) >> 2)) * 64;
    const int NT = (q0 + 256) / 64;
    DMA_K(0, 0); DMA_V(0, 0); DMA_K(1, AT_SLOT);
    bf16x8 qr[6];
#pragma unroll
    for (int d0 = 0; d0 < 6; ++d0) qr[d0] = *(const bf16x8*)(Qw + (size_t)r32 * QPITCH + d0 * 16 + hi * 8);
    float mhat = 0.f, l_reg = 0.f; f32x16 o[2], negm;
    { float z = 0.f; asm volatile("" : "+v"(z));
#pragma unroll
      for (int r = 0; r < 16; ++r) { o[0][r] = z; o[1][r] = z; negm[r] = z; } }
    AT_PIN(negm);
    const int qrel = wid * 32 + r32; bool resc = false;
    f32x16 pA0, pA1, pB0, pB1; bf16x8 kf[12]; bf16x4 vlo[8], vhi[8]; v4u pw0, pw1, pw2, pw3;
    int sl_prev = 0, sl_cur = 0, sl_next = AT_SLOT;
#define ROT() do { sl_prev = sl_cur; sl_cur = sl_next; sl_next = (sl_next == 2 * AT_SLOT) ? 0 : sl_next + AT_SLOT; } while (0)
#define RESC() do { if (resc) { LDS_WAIT(); _Pragma("unroll") for (int d_ = 0; d_ < 2; ++d_) _Pragma("unroll") for (int r = 0; r < 16; ++r) o[d_][r] *= wsf[at_crow(r, hi)]; } } while (0)
#define CMASKB(P0, P1, t) do { const int jb_ = (t) - (NT - 4); if (jb_ >= 0) at_cmask(P0, P1, jb_, qrel, hi); } while (0)
    DMA_K(2, 2 * AT_SLOT);
    AT_WAIT_BAR(5);
#pragma unroll
    for (int d0 = 0; d0 < 6; ++d0) at_kload2(kf, kp0, d0);
    pA0 = AT_MFMA(kf[0], qr[0], negm); pA1 = AT_MFMA(kf[1], qr[0], negm);
#pragma unroll
    for (int d0 = 1; d0 < 6; ++d0) { pA0 = AT_MFMA(kf[2 * d0], qr[d0], pA0); pA1 = AT_MFMA(kf[2 * d0 + 1], qr[d0], pA1); }
    CMASKB(pA0, pA1, 0);
    { const float rm = at_rowmax(pA0, pA1); mhat = rm;
#pragma unroll
      for (int r = 0; r < 16; ++r) { pA0[r] = __builtin_amdgcn_exp2f(pA0[r] - rm); pA1[r] = __builtin_amdgcn_exp2f(pA1[r] - rm); negm[r] = -rm; }
      AT_PIN(negm); }
    AT_WAIT_BAR(0);
    DMA_K(3, 0); DMA_V(1, AT_SLOT); ROT();
#pragma unroll
    for (int d0 = 0; d0 < 6; ++d0) at_kload2(kf, kp0 + sl_cur, d0);
    AT_WAIT_BAR(3);
#define PKW(P, i) pk2(P[i], P[(i) + 1])
#define PAF(k) __builtin_bit_cast(bf16x8, pw##k)
#define VFR(i) (bf16x8){vlo[i][0], vlo[i][1], vlo[i][2], vlo[i][3], vhi[i][0], vhi[i][1], vhi[i][2], vhi[i][3]}
#define VRD(i) do { vlo[i] = at_vtr(vp_ + (((i) >> 2) * 4096 + ((i) & 3) * 1024)); vhi[i] = at_vtr(vp_ + (((i) >> 2) * 4096 + ((i) & 3) * 1024 + 512)); } while (0)
#define KRD(G, j) do { if (G) { at_kload2(kf, kp0 + sl_next, j); AT_SBAR(); } } while (0)
#define GAPA(MF, a0, a1, a2, a3, W0, W1, PW) do { MF; sacc += a0; sacc += a1; sacc += a2; sacc += a3; AT_PIN(sacc); W0; W1; AT_PIN(PW); AT_SBAR(); } while (0)
#define EX(v) __builtin_amdgcn_exp2f(v)
#define GAPB(MF, X, i) do { MF; X[i] = EX(X[i]); X[(i) + 1] = EX(X[(i) + 1]); X[(i) + 2] = EX(X[(i) + 2]); X[(i) + 3] = EX(X[(i) + 3]); AT_PIN(X); AT_SBAR(); } while (0)
#define STEP(C0, C1, P0, P1, t, MASK, GK, GV, GL) do { AT_SBAR(); \
    const at_lptr vp_ = vp0 + sl_prev; \
    VRD(0); AT_SBAR(); float sacc = P0[0] + P0[1]; \
                       GAPA(C0 = AT_MFMA(kf[0], qr[0], negm), P0[2], P0[3], P0[4], P0[5],     pw0[0] = PKW(P0, 0),  pw0[1] = PKW(P0, 2),  pw0); \
    VRD(4); AT_SBAR(); GAPA(C1 = AT_MFMA(kf[1], qr[0], negm), P0[6], P0[7], P0[8], P0[9],     pw0[2] = PKW(P0, 4),  pw0[3] = PKW(P0, 6),  pw0); \
    VRD(1); AT_SBAR(); GAPA(C0 = AT_MFMA(kf[2], qr[1], C0),   P0[10], P0[11], P0[12], P0[13], pw1[0] = PKW(P0, 8),  pw1[1] = PKW(P0, 10), pw1); \
    VRD(5); AT_SBAR(); GAPA(C1 = AT_MFMA(kf[3], qr[1], C1),   P0[14], P0[15], P1[0], P1[1],   pw1[2] = PKW(P0, 12), pw1[3] = PKW(P0, 14), pw1); \
    VRD(2); AT_SBAR(); GAPA(C0 = AT_MFMA(kf[4], qr[2], C0),   P1[2], P1[3], P1[4], P1[5],     pw2[0] = PKW(P1, 0),  pw2[1] = PKW(P1, 2),  pw2); \
    VRD(6); AT_SBAR(); GAPA(C1 = AT_MFMA(kf[5], qr[2], C1),   P1[6], P1[7], P1[8], P1[9],     pw2[2] = PKW(P1, 4),  pw2[3] = PKW(P1, 6),  pw2); \
    VRD(3); AT_SBAR(); GAPA(C0 = AT_MFMA(kf[6], qr[3], C0),   P1[10], P1[11], P1[12], P1[13], pw3[0] = PKW(P1, 8),  pw3[1] = PKW(P1, 10), pw3); \
    VRD(7); AT_SBAR(); GAPA(C1 = AT_MFMA(kf[7], qr[3], C1),   P1[14], P1[15], 0.f, 0.f,       pw3[2] = PKW(P1, 12), pw3[3] = PKW(P1, 14), pw3); \
    C0 = AT_MFMA(kf[8], qr[4], C0); C1 = AT_MFMA(kf[9], qr[4], C1); C0 = AT_MFMA(kf[10], qr[5], C0); C1 = AT_MFMA(kf[11], qr[5], C1); AT_SBAR();     \
    l_reg += sacc; \
    if (GK) DMA_K((t) + 3, sl_cur); if (GV) DMA_V((t) + 1, sl_next);                                         \
    if (MASK) CMASKB(C0, C1, t); \
    { const float rm = at_rowmax(C0, C1); resc = false;                                                       \
      if (__builtin_expect(__any(rm > (float)AT_THR), 0)) { const float dl = __builtin_fmaxf(rm, 0.f); mhat += dl;     \
          _Pragma("unroll") for (int r = 0; r < 16; ++r) { C0[r] -= dl; C1[r] -= dl; } \
          _Pragma("unroll") for (int r = 0; r < 16; ++r) negm[r] = -mhat; AT_PIN(negm); \
          const float f = __builtin_amdgcn_exp2f(-dl); l_reg *= f; if (hi == 0) wsf[r32] = f; resc = true; } } \
    AT_SBAR(); \
    GAPB(o[0] = AT_MFMA(PAF(0), VFR(0), o[0]), C0, 0);               GAPB(o[1] = AT_MFMA(PAF(0), VFR(4), o[1]), C0, 4); \
    KRD(GL, 0); GAPB(o[0] = AT_MFMA(PAF(1), VFR(1), o[0]), C0, 8);   KRD(GL, 1); GAPB(o[1] = AT_MFMA(PAF(1), VFR(5), o[1]), C0, 12); \
    KRD(GL, 2); GAPB(o[0] = AT_MFMA(PAF(2), VFR(2), o[0]), C1, 0);   KRD(GL, 3); GAPB(o[1] = AT_MFMA(PAF(2), VFR(6), o[1]), C1, 4); \
    KRD(GL, 4); GAPB(o[0] = AT_MFMA(PAF(3), VFR(3), o[0]), C1, 8);   KRD(GL, 5); GAPB(o[1] = AT_MFMA(PAF(3), VFR(7), o[1]), C1, 12); \
    } while (0)
    int t = 1;
    for (; t + 5 < NT; t += 2) {
        STEP(pB0, pB1, pA0, pA1, t, false, true, true, true);     AT_WAIT_BAR(3); RESC(); ROT();
        STEP(pA0, pA1, pB0, pB1, t + 1, false, true, true, true); AT_WAIT_BAR(3); RESC(); ROT();
    }
#define ENDW(tt) do { if ((tt) + 3 < NT) { AT_WAIT_BAR(3); } else if ((tt) + 2 < NT) { AT_WAIT_BAR(1); } else { AT_WAIT_BAR(0); } } while (0)
    for (; t + 1 < NT; t += 2) {
        STEP(pB0, pB1, pA0, pA1, t, true, (t + 3 < NT), (t + 1 < NT), (t + 1 < NT));         ENDW(t);     RESC(); ROT();
        STEP(pA0, pA1, pB0, pB1, t + 1, true, (t + 4 < NT), (t + 2 < NT), (t + 2 < NT));     ENDW(t + 1); RESC(); ROT();
    }
    STEP(pB0, pB1, pA0, pA1, NT - 1, true, false, false, false); RESC();
    { float sacc = pB0[0] + pB0[1];
#pragma unroll
      for (int r = 2; r < 16; ++r) sacc += pB0[r];
#pragma unroll
      for (int r = 0; r < 16; ++r) sacc += pB1[r];
      l_reg += sacc;
      pw0 = (v4u){PKW(pB0, 0), PKW(pB0, 2), PKW(pB0, 4), PKW(pB0, 6)}; pw1 = (v4u){PKW(pB0, 8), PKW(pB0, 10), PKW(pB0, 12), PKW(pB0, 14)};
      pw2 = (v4u){PKW(pB1, 0), PKW(pB1, 2), PKW(pB1, 4), PKW(pB1, 6)}; pw3 = (v4u){PKW(pB1, 8), PKW(pB1, 10), PKW(pB1, 12), PKW(pB1, 14)};
      const at_lptr vp_ = vp0 + sl_cur;
#pragma unroll
      for (int i = 0; i < 8; ++i) VRD(i);
      o[0] = AT_MFMA(PAF(0), VFR(0), o[0]); o[1] = AT_MFMA(PAF(0), VFR(4), o[1]); o[0] = AT_MFMA(PAF(1), VFR(1), o[0]); o[1] = AT_MFMA(PAF(1), VFR(5), o[1]);
      o[0] = AT_MFMA(PAF(2), VFR(2), o[0]); o[1] = AT_MFMA(PAF(2), VFR(6), o[1]); o[0] = AT_MFMA(PAF(3), VFR(3), o[0]); o[1] = AT_MFMA(PAF(3), VFR(7), o[1]); }
    { auto rr = __builtin_amdgcn_permlane32_swap(__float_as_uint(l_reg), __float_as_uint(l_reg), false, false); l_reg = __uint_as_float(rr[0]) + __uint_as_float(rr[1]); }
    if (hi == 0) wsf[32 + r32] = l_reg;
    LDS_WAIT();
    float rli[16];
#pragma unroll
    for (int r = 0; r < 16; ++r) rli[r] = __builtin_amdgcn_rcpf(wsf[32 + at_crow(r, hi)]);
    LAS bf16* stg = (LAS bf16*)(shm + AT_OST) + wid * 2048;
    bf16* Ow = (bf16*)(ws + WS_YCAT) + (rowbase + q0 + wid * 32) * D + RWD + h * HD;
#pragma unroll
    for (int r = 0; r < 16; ++r) { const int orow = at_crow(r, hi); const unsigned w = pk2(o[0][r] * rli[r], o[1][r] * rli[r]);
        stg[orow * 64 + r32] = (bf16)(w & 0xffffu); stg[orow * 64 + 32 + r32] = (bf16)(w >> 16); }
    LDS_WAIT();
#pragma unroll
    for (int i = 0; i < 4; ++i) { const int row = i * 8 + (lane >> 3), ch = lane & 7; *(v4u*)(Ow + (size_t)row * D + ch * 8) = *(const LAS v4u*)(stg + row * 64 + ch * 8); }
    asm volatile("s_waitcnt lgkmcnt(0)\n\ts_barrier" ::: "memory");
#undef DMA_K
#undef DMA_V
#undef ROT
#undef RESC
#undef CMASKB
#undef PKW
#undef PAF
#undef VFR
#undef VRD
#undef KRD
#undef GAPA
#undef EX
#undef GAPB
#undef STEP
#undef ENDW
}
__device__ __forceinline__ void attn_phase(const Frame& F, int bh) {
    for (int qb = SEQ / 256 - 1; qb >= 0; --qb) attn_unit(F, bh >> 3, bh & 7, qb);
    VM_WAIT(); __syncthreads();
}

constexpr int MOEW_ITEMS = 32 * 16 * 16 + 32 * 4 * 32, MOEW_SPLIT = MOEW_ITEMS / 2;
__device__ __forceinline__ void p5_moe_weights(const Frame& F, const float* w_gu, const float* w_down, const float* ffn_g, int wg, int nwg, int it0, int it1) {
    unsigned char* ws = F.ws; LAS float* scr = (LAS float*)(F.lds + F.wave * 16384);
    const int gw = wg * NWAVES + F.wave, NGW = nwg * NWAVES, lane = F.lane;
    constexpr int I_GU = 32 * 16 * 16, I_DN = 32 * 4 * 32;
    for (int it = it0 + gw; it < it1; it += NGW) {
        int r = it;
        if (r < I_GU) { const int e = r / 256, q = r % 256, kb = q / 16, nb = q % 16, n0 = nb * 32; const int cc = n0 & 255; const int dst = 256 * (cc >> 7) + (n0 >= 256 ? 128 : 0) + (cc & 127);
            p0_transpose_item(w_gu + (size_t)e * D * 512, 512, kb * 64, n0, (bf16*)(ws + WS_WGU) + (size_t)e * 512 * D, D, dst, ffn_g, scr, lane); continue; } r -= I_GU;
        { const int e = r / 128, q = r % 128, kb = q / 32, nb = q % 32;
            p0_transpose_item(w_down + (size_t)e * DEXP * D, D, kb * 64, nb * 32, (bf16*)(ws + WS_WD) + (size_t)e * D * DEXP, DEXP, nb * 32, nullptr, scr, lane); }
    }
}
__device__ __forceinline__ void p9_route(const Frame& F, const float* b_group, const float* b_router, int row0, int nrows) {
    unsigned char* ws = F.ws; const int tid = F.tid;
    const float* LG = (const float*)(ws + WS_LOGITS);
    int* ROUTE = (int*)(ws + WS_ROUTE); int* TB = (int*)(ws + WS_TOK2); float* WB = (float*)(ws + WS_WB2); float* RSB = (float*)(ws + WS_RSB2); const float* SS = (const float*)(ws + WS_SQ);
    LAS int* hist = (LAS int*)(F.lds + MISC_OFF + 192); LAS int* base = (LAS int*)(F.lds + MISC_OFF + 320);
    if (tid < 32) hist[tid] = 0;
    __syncthreads();
    int e1 = 0, e2 = 0, l1 = 0, l2 = 0; float w1 = 0.f, w2 = 0.f; const bool act = tid < nrows; const int m = row0 + tid;
    if (act) {
        const float* lg = LG + (size_t)m * 64;
        float g[4]; int gs = 0; float gm;
#pragma unroll
        for (int j = 0; j < 4; ++j) g[j] = lg[j] + b_group[j];
        gm = g[0];
#pragma unroll
        for (int j = 1; j < 4; ++j) if (g[j] > gm) { gm = g[j]; gs = j; }
        float den = 0.f;
#pragma unroll
        for (int j = 0; j < 4; ++j) den += __expf(g[j] - gm);
        const float gate_g = 1.f / den;
        float f[8];
#pragma unroll
        for (int j = 0; j < 8; ++j) f[j] = lg[4 + 8 * gs + j] + b_router[8 * gs + j];
        int i1 = 0; float v1 = f[0];
#pragma unroll
        for (int j = 1; j < 8; ++j) if (f[j] > v1) { v1 = f[j]; i1 = j; }
        int i2 = -1; float v2 = -INFINITY;
#pragma unroll
        for (int j = 0; j < 8; ++j) if (j != i1 && f[j] > v2) { v2 = f[j]; i2 = j; }
        const float ex = __expf(v2 - v1); w1 = gate_g / (1.f + ex); w2 = gate_g * ex / (1.f + ex);
        e1 = 8 * gs + i1; e2 = 8 * gs + i2;
        l1 = atomicAdd((int*)(hist + e1), 1); l2 = atomicAdd((int*)(hist + e2), 1);
    }
    __syncthreads();
    if (tid < 32) base[tid] = (int)__hip_atomic_fetch_add((unsigned*)(F.ctl + CW_CNT + tid), (unsigned)hist[tid], RLX_AGENT);
    __syncthreads();
    if (act) { const int r1 = base[e1] + l1, r2 = base[e2] + l2; *(int4*)(ROUTE + (size_t)m * 4) = make_int4(e1, e2, r1, r2);
        const float rs = 1.f / sqrtf(SS[m] * (1.f / D) + NORM_EPS); const int d1 = e1 * MOE_CAP + r1, d2 = e2 * MOE_CAP + r2;
        TB[d1] = m; TB[d2] = m; WB[d1] = w1; WB[d2] = w2; RSB[d1] = rs; RSB[d2] = rs; }
}
__device__ __forceinline__ void moe_offsets(const Frame& F) {
    LAS int* PE = (LAS int*)(F.lds + MISC_OFF + 64); LAS int* PS = (LAS int*)(F.lds + MISC_OFF + 448); LAS int* BLK = (LAS int*)(F.lds + MISC_OFF + 192);
    if (F.tid < NEXP) { const int c = (int)__hip_atomic_load((unsigned*)(F.ctl + CW_CNT + F.tid), RLX_AGENT); BLK[F.tid] = (c + 255) >> 8; }
    __syncthreads();
    if (F.tid < NEXP) { int accb = 0; for (int e = 0; e < F.tid; ++e) accb += BLK[e]; PS[F.tid] = accb * 256; PE[F.tid] = accb + BLK[F.tid]; }
    __syncthreads();
}
__device__ __forceinline__ void p10_scatter(const Frame& F) {
    unsigned char* ws = F.ws; const int tid = F.tid;
    moe_offsets(F);
    const LAS int* PS = (const LAS int*)(F.lds + MISC_OFF + 448);
    const int* ROUTE = (const int*)(ws + WS_ROUTE); const float* GW = (const float*)(ws + WS_GATEW);
    int* TB = (int*)(ws + WS_TOKBUF); float* WB = (float*)(ws + WS_WBUF); int* POS = (int*)(ws + WS_POS); float* RSB = (float*)(ws + WS_RSB); const float* SS = (const float*)(ws + WS_SQ);
    const int per = M / F.G;
    if (tid < per) { const int m = F.vcu * per + tid; const int4 r = *(const int4*)(ROUTE + (size_t)m * 4); const float2 w = *(const float2*)(GW + (size_t)m * 2);
        const int d1 = PS[r.x] + r.z, d2 = PS[r.y] + r.w;
        const float rs = 1.f / sqrtf(SS[m] * (1.f / D) + NORM_EPS); RSB[d1] = rs; RSB[d2] = rs;
        TB[d1] = m; TB[d2] = m; WB[d1] = w.x; WB[d2] = w.y; *(int2*)(POS + (size_t)m * 2) = make_int2(d1, d2); }
}

__device__ __forceinline__ void p13_final(const Frame& F, const float* fin_g) {
    float* OUT = F.out; const bf16* XB = (const bf16*)(F.ws + WS_XN); const bf16* Y = (const bf16*)(F.ws + WS_Y); const int4* ROUTE = (const int4*)(F.ws + WS_ROUTE); const LAS int* PS = (const LAS int*)(F.lds + MISC_OFF + 448); const int lane = F.lane;
    const int gw = F.vcu * NWAVES + F.wave, NGW = F.G * NWAVES;
    f32x4 gv[4];
#pragma unroll
    for (int j = 0; j < 4; ++j) gv[j] = ((const f32x4*)fin_g + lane)[64 * j];
    asm volatile("" : "+v"(gv[0]), "+v"(gv[1]), "+v"(gv[2]), "+v"(gv[3]));
    int4 rna = make_int4(0, 0, 0, 0), rnb = rna;
    if (gw < M) { rna = ROUTE[gw]; rnb = ROUTE[gw + NGW < M ? gw + NGW : gw]; }
    for (int m = gw; m < M; m += 2 * NGW) {
        const int m2 = m + NGW;
        const bool has2 = m2 < M; const int mb = has2 ? m2 : m;
        const int4 ra_ = rna, rb_ = rnb;
        { const int mn = m + 2 * NGW; if (mn < M) { rna = ROUTE[mn]; rnb = ROUTE[mn + NGW < M ? mn + NGW : mn]; } } const int2 pa = make_int2(PS[ra_.x] + ra_.z, PS[ra_.y] + ra_.w), pb = make_int2(PS[rb_.x] + rb_.z, PS[rb_.y] + rb_.w);
        const v2u* xa = (const v2u*)(XB + (size_t)m * D) + lane; const v2u* ya1 = (const v2u*)(Y + (size_t)pa.x * D) + lane; const v2u* ya2 = (const v2u*)(Y + (size_t)pa.y * D) + lane;
        const v2u* xb = (const v2u*)(XB + (size_t)mb * D) + lane; const v2u* yb1 = (const v2u*)(Y + (size_t)pb.x * D) + lane; const v2u* yb2 = (const v2u*)(Y + (size_t)pb.y * D) + lane;
        v2u ax[4], a1[4], a2[4], bx[4], b1[4], b2[4];
#pragma unroll
        for (int j = 0; j < 4; ++j) { ax[j] = xa[64 * j]; a1[j] = ya1[64 * j]; a2[j] = ya2[64 * j]; bx[j] = xb[64 * j]; b1[j] = yb1[64 * j]; b2[j] = yb2[64 * j]; }
        f32x4 va[4], vb[4]; float sa = 0.f, sb = 0.f;
#pragma unroll
        for (int j = 0; j < 4; ++j) {
            va[j].x = bflo(ax[j].x) + (bflo(a1[j].x) + bflo(a2[j].x)); va[j].y = bfhi(ax[j].x) + (bfhi(a1[j].x) + bfhi(a2[j].x)); va[j].z = bflo(ax[j].y) + (bflo(a1[j].y) + bflo(a2[j].y)); va[j].w = bfhi(ax[j].y) + (bfhi(a1[j].y) + bfhi(a2[j].y));
            vb[j].x = bflo(bx[j].x) + (bflo(b1[j].x) + bflo(b2[j].x)); vb[j].y = bfhi(bx[j].x) + (bfhi(b1[j].x) + bfhi(b2[j].x)); vb[j].z = bflo(bx[j].y) + (bflo(b1[j].y) + bflo(b2[j].y)); vb[j].w = bfhi(bx[j].y) + (bfhi(b1[j].y) + bfhi(b2[j].y));
            sa += (va[j].x * va[j].x + va[j].y * va[j].y) + (va[j].z * va[j].z + va[j].w * va[j].w); sb += (vb[j].x * vb[j].x + vb[j].y * vb[j].y) + (vb[j].z * vb[j].z + vb[j].w * vb[j].w); }
        const float ra = 1.f / sqrtf(wave_sum(sa) * (1.f / D) + NORM_EPS), rb = 1.f / sqrtf(wave_sum(sb) * (1.f / D) + NORM_EPS);
        f32x4* oa = (f32x4*)(OUT + (size_t)m * D) + lane; f32x4* ob = (f32x4*)(OUT + (size_t)mb * D) + lane;
#pragma unroll
        for (int j = 0; j < 4; ++j) { const f32x4 g = gv[j]; oa[64 * j] = va[j] * ra * g; if (has2) ob[64 * j] = vb[j] * rb * g; }
    }
}

struct Args { const void* in[30]; float* out; unsigned char* ws; int ph_lo, ph_hi; };
enum { IN_X = 0, IN_POS, IN_MIXG, IN_WIN, IN_MU, IN_W0, IN_WUP, IN_A0, IN_AUP, IN_GUP, IN_KK, IN_KA, IN_RK, IN_GNW, IN_GNB, IN_GQA, IN_WQUP, IN_GKVA, IN_WKVUP,
       IN_WBR, IN_WBM, IN_WOUT, IN_FFNG, IN_WGRP, IN_BGRP, IN_WRT, IN_BRT, IN_WGU, IN_WDN, IN_FING };

__global__ void __launch_bounds__(NWAVES * 64, 2) hybrid_fwd(Args args) {
    extern __shared__ __attribute__((aligned(16))) unsigned char lds[];
    Frame F;
    F.lds = (LAS unsigned char*)lds;
    F.tid = threadIdx.x; F.lane = F.tid & 63; F.wave = __builtin_amdgcn_readfirstlane(F.tid >> 6);
    F.G = gridDim.x; { const int bx = blockIdx.x; F.vcu = (F.G % 8 == 0) ? (bx % 8) * (F.G / 8) + bx / 8 : bx; }
    F.out = args.out; F.ws = args.ws; F.ctl = (gu32*)(args.ws + WS_CTL); F.in = nullptr;
    unsigned char* ws = args.ws;
    for (int u = F.tid; u < 256; u += NWAVES * 64) ((LAS unsigned*)(F.lds + MISC_OFF))[u] = 0u;
    __syncthreads();
    XcdBarrier bar; bar.bar = (unsigned*)(F.ctl + CW_BAR); bar.x = 0; bar.st = nullptr;
    if (N_LAUNCHES == 1) bar = xcd_barrier_post((unsigned*)(F.ctl + CW_BAR), (volatile LAS unsigned*)(F.lds + MISC_OFF));
#define GRID_BAR() do { if (N_LAUNCHES == 1) xcd_barrier(bar); } while (0)
    const int lo = args.ph_lo, hi = args.ph_hi;
#ifndef PHASE_MASK
#define PHASE_MASK 0xFFFF
#endif
#define IN(k) ((((PHASE_MASK) >> (k)) & 1) && lo <= (k) && (k) < hi)
#define BOTH(k) (IN(k) && IN((k) + 1))
#define INF(i) ((const float*)args.in[i])
    LAS unsigned char* ring = F.lds;
    const int bx = (int)blockIdx.x;

    if (IN(0)) {
        P0In I{INF(IN_FFNG), INF(IN_X), INF(IN_MIXG), INF(IN_WIN), INF(IN_WUP), INF(IN_AUP), INF(IN_GUP), INF(IN_GQA), INF(IN_WQUP), INF(IN_GKVA), INF(IN_WKVUP), INF(IN_WBR), INF(IN_WBM), INF(IN_WOUT),
               INF(IN_WGRP), INF(IN_WRT), INF(IN_WGU), INF(IN_WDN), (const int*)args.in[IN_POS]};
        p0_prologue(F, I);
        if (BOTH(0)) GRID_BAR();
    }
    if (IN(1)) {
        pg8::Gemm g{(const bf16*)(ws + WS_XN), (const bf16*)(ws + WS_WIN) + (size_t)1024 * D, D, D, D, 0, nullptr}; pg8::StaticOrder S; S.init(M, 1024 + NRWM, F.G, bx);
        EpiP1 E{ws + WS_GATEB, (bf16*)(ws + WS_RKV), (bf16*)(ws + WS_REST)};
        pg8::gemm_phase<EpiP1, pg8::StaticOrder, true, false>(ring, g, S, E);
        if (BOTH(1)) GRID_BAR();
    }
    if (IN(2)) {
        P2In I{INF(IN_MU), INF(IN_W0), INF(IN_A0)};
        p2_prep(F, I);
        if (BOTH(2)) GRID_BAR();
    }
    if (IN(3)) {
#ifndef P3SEL
#define P3SEL 7
#endif
        if (P3SEL & 1) { pg8::Gemm g{(const bf16*)(ws + WS_REST) + R_Q, (const bf16*)(ws + WS_WQ), QL, NREST, QL, 0, nullptr}; pg8::StaticOrder S; S.init(M, QPITCH, F.G, bx);
          EpiQ E{(bf16*)(ws + WS_Q), (const float*)(ws + WS_SQ), (const float*)(ws + WS_COS), (const float*)(ws + WS_SIN)};
          pg8::gemm_phase<EpiQ, pg8::StaticOrder, true, false>(ring, g, S, E); }
        if (P3SEL & 2) { pg8::Gemm g{(const bf16*)(ws + WS_REST) + R_KV, (const bf16*)(ws + WS_WKN), KVL, NREST, KVL, 0, nullptr};
          const int nq2 = (M / 256) * (QPITCH / 256) - F.G;
          pg8::RangeOrder S{0, 0, 4};
          if (F.G == 256 && nq2 == 128) { if (bx < 128) { S.base = bx; S.cnt = 1; } else { S.base = 128 + (bx - 128) * 3; S.cnt = 3; } }
          else { S.base = bx * ((M / 256) * 4 / F.G); S.cnt = (M / 256) * 4 / F.G; if (bx == F.G - 1) S.cnt = (M / 256) * 4 - S.base; }
          EpiKn E{(bf16*)(ws + WS_K), (const float*)(ws + WS_SKV)};
          pg8::gemm_phase<EpiKn, pg8::RangeOrder, true, false>(ring, g, S, E); }
        if (BOTH(3)) GRID_BAR();
    }
    if (IN(4)) {
        const int nb = BATCH * NH, half = F.G / 2;
        if (F.vcu < half) { ScanIn I{INF(IN_MU), INF(IN_KK), INF(IN_KA), INF(IN_RK), INF(IN_GNW), INF(IN_GNB)}; for (int bh = F.vcu; bh < nb; bh += half) scan_phase(F, I, bh); }
        else { for (int bh = F.vcu - half; bh < nb; bh += F.G - half) attn_phase(F, bh); }
        { pg8::Gemm g{(const bf16*)(ws + WS_XN), (const bf16*)(ws + WS_WIN), D, D, D, 0, nullptr};
          EpiGate8 E{ws + WS_GATEA};
          volatile LAS int* qw = (volatile LAS int*)(F.lds + MISC_OFF + 32);
          constexpr int NU = (M / 256) * 4;
          const int nstat = ((F.G - half) * 3 + half <= NU && F.G == 2 * half) ? (F.G - half) * 3 + half : 0;
          if (nstat) { pg8::RangeOrder S{F.vcu >= half ? (F.vcu - half) * 3 : (F.G - half) * 3 + F.vcu, F.vcu >= half ? 3 : 1, 4}; pg8::gemm_phase<EpiGate8, pg8::RangeOrder, true, false>(ring, g, S, E); }
          if (nstat < NU)
          for (;;) {
              __syncthreads();
              if (F.tid == 0) { const unsigned sz = nstat ? 1u : 2u;
                  qw[0] = nstat + (int)__hip_atomic_fetch_add((unsigned*)(F.ctl + CW_GQ), sz, RLX_AGENT); qw[1] = (int)sz; }
              __syncthreads();
              const int L = qw[0]; int n = qw[1];
              if (L >= NU) break;
              if (L + n > NU) n = NU - L;
              pg8::RangeOrder S{L, n, 4};
              pg8::gemm_phase<EpiGate8, pg8::RangeOrder, true, false>(ring, g, S, E);
          } }
        if (BOTH(4)) GRID_BAR();
    }
    if (IN(5)) {
        bf16* MG = (bf16*)(ws + WS_MERGED);
        p5_moe_weights(F, INF(IN_WGU), INF(IN_WDN), INF(IN_FFNG), F.vcu, F.G, MOEW_SPLIT, MOEW_ITEMS);
        { float* SS = (float*)(ws + WS_SQ); for (int i = F.vcu * (NWAVES * 64) + F.tid; i < M; i += F.G * NWAVES * 64) SS[i] = 0.f; }
        __syncthreads();
        pg8::StaticOrder S; S.init(M, D, F.G, bx);
        { pg8::Gemm g{(const bf16*)(ws + WS_YCAT), (const bf16*)(ws + WS_WBR), D, D, D, 0, nullptr}; EpiMerge2 E{ws + WS_GATEA, ws + WS_GATEB, MG};
          pg8::gemm_phase<EpiMerge2, pg8::StaticOrder, true, false, true>(ring, g, S, E); }
        if (BOTH(5)) GRID_BAR();
    }
    if (IN(6)) {
        pg8::Gemm g{(const bf16*)(ws + WS_MERGED), (const bf16*)(ws + WS_WO), D, D, D, 0, nullptr}; pg8::StaticOrder S; S.init(M, D, F.G, bx);
        EpiXmid E{(const float*)(ws + WS_RINV), (bf16*)(ws + WS_XN), (float*)(ws + WS_SQ)};
        pg8::gemm_phase<EpiXmid, pg8::StaticOrder, true, false>(ring, g, S, E);
        if (BOTH(6)) GRID_BAR();
    }
    if (IN(8)) {
        pg8::Gemm g{(const bf16*)(ws + WS_XN), (const bf16*)(ws + WS_WR), D, D, D, 0, nullptr}; pg8::StaticOrder S; S.init(M, 256, F.G, bx);
        EpiLogits E{(float*)(ws + WS_LOGITS), (const float*)(ws + WS_SQ)};
        pg8::gemm_phase<EpiLogits, pg8::StaticOrder, true, false>(ring, g, S, E);
        if (bx >= S.nwg && F.G > S.nwg) p5_moe_weights(F, INF(IN_WGU), INF(IN_WDN), INF(IN_FFNG), bx - S.nwg, F.G - S.nwg, 0, MOEW_SPLIT);
        else if (F.G <= S.nwg) p5_moe_weights(F, INF(IN_WGU), INF(IN_WDN), INF(IN_FFNG), F.vcu, F.G, 0, MOEW_SPLIT);
        VM_WAIT(); __syncthreads();
        pg8::Unit u; for (int i = 0; S.next(i, u); ++i) { p9_route(F, INF(IN_BGRP), INF(IN_BRT), u.pm * 256, 256); __syncthreads(); }
        if (BOTH(8)) GRID_BAR();
    }
    if (IN(11)) {
        moe_offsets(F);
        const LAS int* PE = (const LAS int*)(F.lds + MISC_OFF + 64); const int nblk = PE[31], nfull = nblk < 256 ? nblk : 256;
        pg8::Gemm g{(const bf16*)(ws + WS_XN), (const bf16*)(ws + WS_WGU), D, D, D, (size_t)512 * D, (const int*)(ws + WS_TOK2)};
        pg8::MoeList S{PE, 2, bx, F.G, nfull * 2};
        EpiSwiglu E{(bf16*)(ws + WS_ACT), (const float*)(ws + WS_RSB2)};
        pg8::gemm_phase<EpiSwiglu, pg8::MoeList, true, true>(ring, g, S, E);
        if (BOTH(11)) GRID_BAR();
    }
    if (IN(12)) {
        moe_offsets(F);
        const LAS int* PE = (const LAS int*)(F.lds + MISC_OFF + 64); const int nblk = PE[31], ntail = nblk > 256 ? nblk - 256 : 0, nch = 2 * ntail < F.G ? 2 * ntail : 0;
        const bool chain = bx < nch; const int rbT = 256 + (bx >> 1), hf = bx & 1;
        if (chain) {
            pg8::Gemm g{(const bf16*)(ws + WS_XN), (const bf16*)(ws + WS_WGU), D, D, D, (size_t)512 * D, (const int*)(ws + WS_TOK2)};
            pg8::MoeList S{PE, 2, rbT * 2 + hf, 1, rbT * 2 + hf + 1};
            EpiSwiglu E{(bf16*)(ws + WS_ACT), (const float*)(ws + WS_RSB2)};
            pg8::gemm_phase<EpiSwiglu, pg8::MoeList, true, true>(ring, g, S, E);
            pair_barrier((unsigned*)(F.ctl + CW_PAIR + (bx >> 1) * 64), (unsigned*)(F.ctl + CW_BAR));
        }
        pg8::Gemm g{(const bf16*)(ws + WS_ACT), (const bf16*)(ws + WS_WD), DEXP, DEXP, DEXP, (size_t)D * DEXP, nullptr};
        pg8::MoeList S{PE, 4, chain ? rbT * 4 + 2 * hf : bx - nch, chain ? 1 : F.G - nch, chain ? rbT * 4 + 2 * hf + 2 : (nblk < 256 ? nblk : 256) * 4};
        EpiDown E{(bf16*)(ws + WS_Y), (const float*)(ws + WS_WB2)};
        pg8::gemm_phase<EpiDown, pg8::MoeList, true, false>(ring, g, S, E);
        if (BOTH(12)) GRID_BAR();
    }
    if (IN(13)) { moe_offsets(F); p13_final(F, INF(IN_FING)); }
#undef IN
#undef BOTH
#undef INF
#undef GRID_BAR
}

extern "C" void kernel_launch(void* const* d_in, const int* in_sizes, int n_in, void* d_out, int out_size, void* d_ws, size_t ws_size, hipStream_t stream) {
    static int grid = 0;
    if (grid == 0) {
        if (n_in != 30 || in_sizes[0] != M * D || out_size != M * D || ws_size < WS_END) { fprintf(stderr, "kernel_launch: unexpected shapes (n_in %d, in0 %d, out %d, ws %zu); nothing launched\n", n_in, n_in > 0 ? in_sizes[0] : -1, out_size, ws_size); grid = -1; return; }
        int dev = 0, cus = 0, per_cu = 0;
        if (hipGetDevice(&dev) != hipSuccess || hipDeviceGetAttribute(&cus, hipDeviceAttributeMultiprocessorCount, dev) != hipSuccess) { grid = -1; return; }
        if (hipFuncSetAttribute((const void*)hybrid_fwd, hipFuncAttributeMaxDynamicSharedMemorySize, LDS_BYTES) != hipSuccess) { fprintf(stderr, "kernel_launch: hipFuncSetAttribute failed\n"); grid = -1; return; }
        if (hipOccupancyMaxActiveBlocksPerMultiprocessor(&per_cu, (const void*)hybrid_fwd, NWAVES * 64, LDS_BYTES) != hipSuccess || per_cu < 1)
            fprintf(stderr, "kernel_launch: note: occupancy query reports %d workgroups per CU\n", per_cu);
        (void)hipGetLastError();
        grid = cus;
        if (grid != 256) fprintf(stderr, "kernel_launch: note: %d CUs\n", grid);
    }
    if (grid < 0) return;
    if (hipMemsetAsync((char*)d_ws + WS_CTL, 0, CTL_ZERO_BYTES, stream) != hipSuccess) return;
    Args a{};
    for (int i = 0; i < 30; ++i) a.in[i] = d_in[i];
    a.out = (float*)d_out; a.ws = (unsigned char*)d_ws;
    if (N_LAUNCHES == 1) { a.ph_lo = 0; a.ph_hi = NPH; hipLaunchKernelGGL(hybrid_fwd, dim3(grid), dim3(NWAVES * 64), LDS_BYTES, stream, a); }
    else for (int p = 0; p < NPH; ++p) { a.ph_lo = p; a.ph_hi = p + 1; hipLaunchKernelGGL(hybrid_fwd, dim3(grid), dim3(NWAVES * 64), LDS_BYTES, stream, a); }
}
```

```cpp
#include <hip/hip_runtime.h>
#include <cstdio>
#include <cstdint>

#ifndef MK_N_LAUNCHES
#define MK_N_LAUNCHES 1
#endif

namespace pg8 {
#define PG8_LAS __attribute__((address_space(3)))
typedef unsigned short bf16_t;
typedef short bf16x8 __attribute__((ext_vector_type(8)));
typedef float f32x4 __attribute__((ext_vector_type(4)));
typedef unsigned u32x4 __attribute__((ext_vector_type(4)));
typedef unsigned u32x2 __attribute__((ext_vector_type(2)));
constexpr int BM = 256, BK = 64, HALF = 128, HTB = HALF * BK * 2  , STAGE_BYTES = 8 * HTB, NXCD = 8, WGM = 8;

__host__ __device__ __forceinline__ int lds_byte(int r, int c) { const int st = (r >> 4) * 2 + (c >> 5), rr = r & 15, cc = c & 31, ob = rr * 64 + cc * 2; return st * 1024 + (ob ^ (((ob >> 9) & 1) << 5)); }
__host__ __device__ __forceinline__ void stage_rc(int b, int& R, int& C) { const int st = b / 1024, sb = b % 1024, swz = sb ^ (((sb >> 9) & 1) << 5); R = (st >> 1) * 16 + swz / 64; C = (st & 1) * 32 + (swz % 64) / 2; }
__host__ __device__ __forceinline__ int perm32(int rho) { const int n = rho >> 4, i = rho & 15; return 8 * (i >> 2) + 4 * n + (i & 3); }

struct Unit { int pm, pn, e, gb; };
struct Gemm { const bf16_t* A; const bf16_t* Bt; int K, lda, ldb; size_t estride; const int* gather; };

struct StaticOrder {
    int nM, nN, nwg, G, c;
    __host__ __device__ __forceinline__ void init(int M, int N, int G_, int c_) { nM = M / BM; nN = N / BM; nwg = nM * nN; G = G_; c = c_; }
    __host__ __device__ __forceinline__ bool next(int i, Unit& u) const {
        const long L = (long)i * G + c; if (L >= nwg) return false;
        int wgid = (int)L; { const int q = nwg / NXCD, r = nwg % NXCD, xcd = wgid % NXCD, off = wgid / NXCD; wgid = (xcd < r ? xcd * (q + 1) : r * (q + 1) + (xcd - r) * q) + off; }
        const int nig = WGM * nN, gid = wgid / nig, fm = gid * WGM, gsz = (nM - fm) < WGM ? (nM - fm) : WGM;
        u.pm = fm + ((wgid % nig) % gsz); u.pn = (wgid % nig) / gsz; u.e = 0; u.gb = 0; return true;
    }
};
struct RangeOrder { int base, cnt, nN; __device__ __forceinline__ bool next(int i, Unit& o) const { if (i >= cnt) return false; const int L = base + i; o.pm = L / nN; o.pn = L % nN; o.e = 0; o.gb = 0; return true; } };
constexpr int MOE_CAP = 32768;
struct MoeOrder {
    const PG8_LAS int* pe; int nN, G, c;
    __device__ __forceinline__ bool next(int i, Unit& u) const {
        const int nblk = pe[31]; const long L = (long)i * G + c; if (L >= (long)nblk * nN) return false;
        const int rb = (int)(L / nN); u.pm = rb; u.pn = (int)(L % nN); int e = 0; while (e < 31 && pe[e] <= rb) ++e; u.e = e; u.gb = e * MOE_CAP + (rb - (e ? pe[e - 1] : 0)) * BM; return true;
    }
};

struct MoeList {
    const PG8_LAS int* pe; int nN, L0, stride, lim;
    __device__ __forceinline__ bool next(int i, Unit& u) const {
        const int L = L0 + i * stride; if (L >= lim) return false;
        const int rb = L / nN; u.pm = rb; u.pn = L % nN; int e = 0; while (e < 31 && pe[e] <= rb) ++e; u.e = e;
        u.gb = e * MOE_CAP + (rb - (e ? pe[e - 1] : 0)) * BM; return true;
    }
};
typedef float f32x2c __attribute__((ext_vector_type(2))); typedef __bf16 bf16x2c __attribute__((ext_vector_type(2)));
__device__ __forceinline__ unsigned cvt_pk_bf16(float lo, float hi) { const f32x2c v = {lo, hi}; return __builtin_bit_cast(unsigned, __builtin_convertvector(v, bf16x2c)); }

typedef double f64x2z __attribute__((ext_vector_type(2)));
__device__ __forceinline__ f32x4 zero4() { double lo, hi; asm volatile("v_mov_b64 %0, 0" : "=v"(lo)); asm volatile("v_mov_b64 %0, 0" : "=v"(hi)); const f64x2z d = {lo, hi}; return __builtin_bit_cast(f32x4, d); }
typedef int i32x8 __attribute__((ext_vector_type(8)));
__device__ __forceinline__ i32x8 cat8(bf16x8 lo, bf16x8 hi) { typedef int i32x4 __attribute__((ext_vector_type(4))); const i32x4 a = __builtin_bit_cast(i32x4, lo), b = __builtin_bit_cast(i32x4, hi); return __builtin_shufflevector(a, b, 0, 1, 2, 3, 4, 5, 6, 7); }
struct NoPre { __device__ __forceinline__ void operator()() const {} };
template <class Epi, class Sched, bool ALIGN_EPI, bool GATHER, bool MIDHOOK = false, bool F8 = false, class Pre = NoPre>
__device__ __forceinline__ void gemm_phase(PG8_LAS unsigned char* lds, const Gemm g, const Sched& S, const Epi& E, const Pre& pre = Pre()) {
    const int tid = threadIdx.x, wid = __builtin_amdgcn_readfirstlane(tid >> 6), lane = tid & 63, wr = wid >> 2, wc = wid & 3, fr = lane & 15, fq = lane >> 4;
    const int K = g.K; int nt = K / BK; asm volatile("" : "+s"(nt));
    unsigned voffA[2], voffB[2]; int RA[2], CA[2];
#pragma unroll
    for (int i = 0; i < 2; ++i) { int R, C; stage_rc(tid * 16 + i * 8192, R, C); const int Rb = Epi::PERM ? ((R & ~31) + perm32(R & 31)) : R; RA[i] = R; CA[i] = C;
        voffA[i] = (unsigned)(R * g.lda + C) * 2u; voffB[i] = (unsigned)(Rb * g.ldb + C) * 2u; }
    const size_t kstep = (size_t)(BK * 2);
    const size_t hstepA = GATHER ? (size_t)0 : (size_t)HALF * g.lda * 2, tstepA = GATHER ? (size_t)0 : 2 * hstepA;
    const size_t hstepB = (size_t)HALF * g.ldb * 2, tstepB = 2 * hstepB;
    const unsigned ldsw = (unsigned)wid * 1024u;
    const int aoff = lds_byte(wr * 64 + fr, fq * 8), boff = lds_byte(wc * 32 + fr, fq * 8);
#define PG8_SA(b, h) (((b) * 2 + (h)) * HTB)
#define PG8_SB(b, h) ((4 + (b) * 2 + (h)) * HTB)
#define PG8_STAGE(bufoff, gbase, voff) do { _Pragma("unroll") for (int _i = 0; _i < 2; ++_i) \
        __builtin_amdgcn_global_load_lds((const unsigned*)((const char*)(gbase) + (voff)[_i]), (PG8_LAS unsigned*)(lds + (bufoff) + ldsw + _i * 8192), 16, 0, 0); } while (0)
#define PG8_LDA(dst, b, h) do { _Pragma("unroll") for (int m = 0; m < 4; ++m) _Pragma("unroll") for (int k = 0; k < 2; ++k) dst[m][k] = *(const PG8_LAS bf16x8*)(lds + PG8_SA(b, h) + aoff + m * 2048 + k * 1024); } while (0)
#define PG8_LDB(dst, b, h) do { _Pragma("unroll") for (int n = 0; n < 2; ++n) _Pragma("unroll") for (int k = 0; k < 2; ++k) dst[n][k] = *(const PG8_LAS bf16x8*)(lds + PG8_SB(b, h) + boff + n * 2048 + k * 1024); } while (0)
#define PG8_MMA(ai, bj, At, Bt) do { __builtin_amdgcn_s_setprio(1); _Pragma("unroll") for (int m = 0; m < 4; ++m) _Pragma("unroll") for (int n = 0; n < 2; ++n) { \
        if constexpr (F8) { const i32x8 b8_ = cat8(Bt[n][0], Bt[n][1]), a8_ = cat8(At[m][0], At[m][1]); asm volatile("s_nop 1\n\tv_mfma_f32_16x16x128_f8f6f4 %0, %1, %2, %0" : "+v"(acc[ai][bj][m][n]) : "v"(b8_), "v"(a8_)); } \
        else { _Pragma("unroll") for (int k = 0; k < 2; ++k) acc[ai][bj][m][n] = __builtin_amdgcn_mfma_f32_16x16x32_bf16(Bt[n][k], At[m][k], acc[ai][bj][m][n], 0, 0, 0); } } __builtin_amdgcn_s_setprio(0); } while (0)
#define PG8_WAIT_V(n) asm volatile("s_waitcnt vmcnt(" #n ")" ::: "memory")
#define PG8_WAIT_L(n) asm volatile("s_waitcnt lgkmcnt(" #n ")" ::: "memory")
#define PG8_BAR __builtin_amdgcn_s_barrier()
#define PG8_SCHED __builtin_amdgcn_sched_barrier(0)
    Unit cur, nxt; int ui = 0;
    if (!S.next(0, cur)) { pre(); return; }
    f32x4 acc[2][2][4][2];
#pragma unroll
    for (int a = 0; a < 2; ++a)
#pragma unroll
        for (int b = 0; b < 2; ++b)
#pragma unroll
            for (int m = 0; m < 4; ++m)
#pragma unroll
                for (int n = 0; n < 2; ++n) acc[a][b][m][n] = zero4();
    bf16x8 At[4][2], B0[2][2], B1[2][2];
    unsigned cA0[2], cA1[2], nA0[2], nA1[2];
#pragma unroll
    for (int i = 0; i < 2; ++i) {
        if constexpr (GATHER) { const int t0 = g.gather[cur.gb + RA[i]], t1 = g.gather[cur.gb + HALF + RA[i]];
            cA0[i] = (unsigned)(t0 * g.lda + CA[i]) * 2u; cA1[i] = (unsigned)(t1 * g.lda + CA[i]) * 2u; }
        else { cA0[i] = voffA[i]; cA1[i] = voffA[i]; }
        nA0[i] = cA0[i]; nA1[i] = cA1[i]; }
    const char* cA = (const char*)g.A + (size_t)cur.pm * tstepA; const char* cB = (const char*)g.Bt + (size_t)cur.e * g.estride * 2 + (size_t)cur.pn * tstepB;
    PG8_STAGE(PG8_SB(0, 0), cB, voffB); PG8_STAGE(PG8_SB(0, 1), cB + hstepB, voffB); PG8_STAGE(PG8_SA(0, 0), cA, cA0); PG8_STAGE(PG8_SA(0, 1), cA + hstepA, cA1);
    if (wr == 1) PG8_BAR;
    PG8_WAIT_V(2); PG8_BAR;
    PG8_STAGE(PG8_SB(1, 0), cB + kstep, voffB); PG8_STAGE(PG8_SA(1, 0), cA + kstep, cA0); PG8_STAGE(PG8_SB(1, 1), cB + hstepB + kstep, voffB);
    PG8_WAIT_V(6); PG8_BAR;
    for (;;) {
        const bool has_next = S.next(ui + 1, nxt);
        const char* nA = has_next ? (const char*)g.A + (size_t)nxt.pm * tstepA : cA; const char* nB = has_next ? (const char*)g.Bt + (size_t)nxt.e * g.estride * 2 + (size_t)nxt.pn * tstepB : cB;
        if constexpr (GATHER) {
            if (has_next) {
#pragma unroll
                for (int i = 0; i < 2; ++i) { const int t0 = g.gather[nxt.gb + RA[i]], t1 = g.gather[nxt.gb + HALF + RA[i]];
                    nA0[i] = (unsigned)(t0 * g.lda + CA[i]) * 2u; nA1[i] = (unsigned)(t1 * g.lda + CA[i]) * 2u; }
            } else {
#pragma unroll
                for (int i = 0; i < 2; ++i) { nA0[i] = cA0[i]; nA1[i] = cA1[i]; }
            }
        }
        for (int t = 0; t < nt; t += 2) {
            const bool last = (t == nt - 2);
            if constexpr (MIDHOOK) { if (2 * t == nt) { int fr_ = lane & 15, fq_ = lane >> 4; asm volatile("" : "+v"(fr_), "+v"(fq_)); E.mid(acc, cur, wr, wc, fr_, fq_); } }
            const char* a1 = cA + (size_t)(t + 1) * kstep;
            const char* a2 = last ? nA : cA + (size_t)(t + 2) * kstep; const char* b2 = last ? nB : cB + (size_t)(t + 2) * kstep;
            const char* a3 = a2 + kstep; const char* b3 = b2 + kstep;
            unsigned sA0[2], sA1[2];
#pragma unroll
            for (int i = 0; i < 2; ++i) { if constexpr (GATHER) { sA0[i] = last ? nA0[i] : cA0[i]; sA1[i] = last ? nA1[i] : cA1[i]; } else { sA0[i] = voffA[i]; sA1[i] = voffA[i]; } }
            PG8_LDB(B0, 0, 0); PG8_LDB(B1, 0, 1); PG8_SCHED; PG8_LDA(At, 0, 0); PG8_STAGE(PG8_SA(1, 1), a1 + hstepA, cA1);
            PG8_WAIT_V(8); PG8_WAIT_L(0); PG8_BAR; PG8_MMA(0, 0, At, B0); PG8_MMA(0, 1, At, B1); PG8_BAR; PG8_SCHED;
            PG8_LDA(At, 0, 1); PG8_STAGE(PG8_SB(0, 0), b2, voffB); PG8_STAGE(PG8_SB(0, 1), b2 + hstepB, voffB); PG8_STAGE(PG8_SA(0, 0), a2, sA0);
            PG8_WAIT_V(8); PG8_WAIT_L(0); PG8_BAR; PG8_MMA(1, 0, At, B0); PG8_MMA(1, 1, At, B1); PG8_BAR; PG8_SCHED;
            PG8_LDB(B0, 1, 0); PG8_LDB(B1, 1, 1); PG8_SCHED; PG8_LDA(At, 1, 0); PG8_STAGE(PG8_SA(0, 1), a2 + hstepA, sA1);
            PG8_WAIT_V(8); PG8_WAIT_L(0); PG8_BAR; PG8_MMA(0, 0, At, B0); PG8_MMA(0, 1, At, B1); PG8_BAR; PG8_SCHED;
            PG8_LDA(At, 1, 1); PG8_STAGE(PG8_SB(1, 0), b3, voffB); PG8_STAGE(PG8_SB(1, 1), b3 + hstepB, voffB); PG8_STAGE(PG8_SA(1, 0), a3, sA0);
            PG8_WAIT_V(8); PG8_WAIT_L(0); PG8_BAR; PG8_MMA(1, 0, At, B0); PG8_MMA(1, 1, At, B1); PG8_BAR; PG8_SCHED;
        }
        if constexpr (F8) asm volatile("s_nop 15\n\ts_nop 15" ::: "memory");
        if constexpr (ALIGN_EPI) { if (wr == 0) PG8_BAR; }
        if (ui == 0) pre();
        { int fr_ = lane & 15, fq_ = lane >> 4; asm volatile("" : "+v"(fr_), "+v"(fq_)); E(acc, cur, wr, wc, fr_, fq_); }
        if (!has_next) break;
#pragma unroll
        for (int a = 0; a < 2; ++a)
#pragma unroll
            for (int b = 0; b < 2; ++b)
#pragma unroll
                for (int m = 0; m < 4; ++m)
#pragma unroll
                    for (int n = 0; n < 2; ++n) acc[a][b][m][n] = zero4();
        cur = nxt; cA = nA; cB = nB; ++ui;
#pragma unroll
        for (int i = 0; i < 2; ++i) { cA0[i] = nA0[i]; cA1[i] = nA1[i]; }
        if constexpr (ALIGN_EPI) { if (wr == 1) PG8_BAR; }
    }
    PG8_WAIT_V(0);
    if constexpr (!ALIGN_EPI) { if (wr == 0) PG8_BAR; }
    PG8_BAR;
#undef PG8_SA
#undef PG8_SB
#undef PG8_STAGE
#undef PG8_LDA
#undef PG8_LDB
#undef PG8_MMA
#undef PG8_WAIT_V
#undef PG8_WAIT_L
#undef PG8_BAR
#undef PG8_SCHED
}
}

constexpr int NWAVES = 8;
constexpr int BATCH = 16, SEQ = 2048, D = 1024, M = BATCH * SEQ;
constexpr int RWD = 512, NH = 8, HD = 64, IN_COLS = 4512;
constexpr int QL = 384, KVL = 256, QKD = 96, QPITCH = NH * QKD;
constexpr int NRWM = 2560;
constexpr int NRKV = 1536, NREST = 1024;
constexpr int R_Q = 256, R_KV = 640, R_KR = 896;
constexpr int C_R = 0, C_K = 512, C_V = 1024, C_WD = 1536, C_AD = 1600, C_GD = 1664, C_Q = 1792, C_KV = 2176, C_KR = 2432;
constexpr int NEXP = 32, DEXP = 256, PMAX = 288 * 256;
constexpr float NORM_EPS = 1e-6f, GN_EPS = 64e-5f;
constexpr float QSCALE = 0.10206207261596577f * 1.4426950408889634f;
constexpr int N_LAUNCHES = MK_N_LAUNCHES;
constexpr int NPH = 14;

constexpr size_t MiB = 1u << 20, KiB = 1u << 10;
constexpr size_t WS_CTL = 0, CTL_ZERO_BYTES = 64 * KiB;
constexpr size_t WS_LWUP = 1 * MiB, WS_LAUP = WS_LWUP + 64 * KiB, WS_LGUP = WS_LAUP + 64 * KiB;
constexpr size_t WS_SQ = WS_LGUP + 128 * KiB, WS_SKV = WS_SQ + 128 * KiB;
constexpr size_t WS_ROUTE = WS_SKV + 128 * KiB;
constexpr size_t WS_GATEW = WS_ROUTE + 512 * KiB;
constexpr size_t WS_POS = WS_GATEW + 256 * KiB;
constexpr size_t WS_TOKBUF = WS_POS + 256 * KiB;
constexpr size_t WS_WBUF = WS_TOKBUF + 288 * KiB;
constexpr size_t WS_RSB = WS_WBUF + 288 * KiB;
static_assert(WS_RSB + 288 * KiB <= 4 * MiB, "small region");
constexpr size_t WS_COS = 4 * MiB, WS_SIN = 6 * MiB;
constexpr size_t WS_WIN = 8 * MiB;
constexpr size_t WS_WQ = 17 * MiB;
constexpr size_t WS_WKN = 18 * MiB, WS_WV = WS_WKN + 256 * KiB;
constexpr size_t WS_WBR = 19 * MiB, WS_WO = 21 * MiB, WS_WR = 23 * MiB;
constexpr size_t WS_XN = 24 * MiB;
constexpr size_t WS_RKV = 88 * MiB;
constexpr size_t WS_REST = 184 * MiB;
constexpr size_t WS_GATEA = 184 * MiB, WS_GATEB = 440 * MiB;
constexpr size_t WS_Q = 248 * MiB, WS_K = 296 * MiB;
constexpr size_t WS_RINV = 360 * MiB;
constexpr size_t WS_TOK2 = 361 * MiB, WS_WB2 = 365 * MiB, WS_RSB2 = 369 * MiB;
constexpr size_t WS_YCAT = 376 * MiB;
constexpr size_t WS_WGU = 216 * MiB, WS_WD = 232 * MiB;
constexpr size_t WS_MERGED = 248 * MiB, WS_ACT = 312 * MiB, WS_LOGITS = 348 * MiB;
constexpr size_t WS_Y = 136 * MiB;
constexpr size_t WS_XN8 = 472 * MiB;
constexpr size_t WS_WIN8 = 8 * MiB;
constexpr size_t WS_KROPE = 504 * MiB;
constexpr size_t WS_END = 506 * MiB;
static_assert(WS_XN8 + (size_t)M * D <= WS_KROPE && WS_GATEB + (size_t)M * D <= WS_XN8, "XN8 sits between the mla gates and the rotary keys");
constexpr size_t OUT_DEC = 0, OUT_AA = 64 * MiB, OUT_G = 96 * MiB;
constexpr int CW_CNT = 1024;
constexpr int CW_GQ = 2048;
constexpr int CW_BAR = 4096;
constexpr int CW_PAIR = 8192;

constexpr int RING_BYTES = 131072;
constexpr int MISC_OFF = RING_BYTES;
constexpr int LDS_BYTES = 147456;

#define GAS __attribute__((address_space(1)))
#define LAS __attribute__((address_space(3)))
typedef unsigned short bf16;
typedef unsigned v4u __attribute__((ext_vector_type(4)));
typedef unsigned v2u __attribute__((ext_vector_type(2)));
typedef float f32x4 __attribute__((ext_vector_type(4)));
typedef float f32x2 __attribute__((ext_vector_type(2)));
typedef float f32x16 __attribute__((ext_vector_type(16)));
typedef short bf16x8 __attribute__((ext_vector_type(8)));
typedef short bf16x4 __attribute__((ext_vector_type(4)));
typedef GAS unsigned gu32;
#define RLX_AGENT __ATOMIC_RELAXED, __HIP_MEMORY_SCOPE_AGENT
#define LDS_WAIT() asm volatile("s_waitcnt lgkmcnt(0)" ::: "memory")
#define VM_WAIT() asm volatile("s_waitcnt vmcnt(0)" ::: "memory")
__device__ __forceinline__ unsigned f2bf(float f) { unsigned u = __builtin_bit_cast(unsigned, f); return (u + 0x7fffu + ((u >> 16) & 1u)) >> 16; }
typedef __bf16 bf16x2_t __attribute__((ext_vector_type(2)));
__device__ __forceinline__ unsigned pk2(float lo, float hi) { const f32x2 v = {lo, hi}; return __builtin_bit_cast(unsigned, __builtin_convertvector(v, bf16x2_t)); }
__device__ __forceinline__ float bflo(unsigned w) { return __builtin_bit_cast(float, w << 16); }
__device__ __forceinline__ float bfhi(unsigned w) { return __builtin_bit_cast(float, w & 0xffff0000u); }
__device__ __forceinline__ float sigmoidf_(float x) { return __builtin_amdgcn_rcpf(1.f + __expf(-x)); }
__device__ __forceinline__ float wave_sum(float v) {
#pragma unroll
    for (int o = 1; o < 64; o <<= 1) v += __shfl_xor(v, o);
    return v;
}

#define XB_TMO      128
#define XB_XCNT(j)  (256  + 64 * (j))
#define XB_XSUB(j)  (1280 + 64 * (j))
#define XB_XGEN(j)  (2304 + 64 * (j))
#define XB_TOP      3328
#define XB_TOPGEN   3392
#define XCD_BAR_WORDS 3456
#define XB_SPIN_CAP (1u << 18)

__device__ __forceinline__ unsigned xb_ld(unsigned* p)              { return __hip_atomic_load(p, __ATOMIC_RELAXED, __HIP_MEMORY_SCOPE_AGENT); }
__device__ __forceinline__ unsigned xb_add(unsigned* p, unsigned v) { return __hip_atomic_fetch_add(p, v, __ATOMIC_RELAXED, __HIP_MEMORY_SCOPE_AGENT); }
__device__ __forceinline__ unsigned xb_xcc_id() { return (unsigned)__builtin_amdgcn_s_getreg((3 << 11) | 20) & 0xFu; }
#define XB_SPIN(cond, bar) do { unsigned _sp = 0; while (cond) { __builtin_amdgcn_s_sleep(1); \
    if ((++_sp & 255u) == 0u) { if (xb_ld(&(bar)[XB_TMO])) break; if (_sp > XB_SPIN_CAP) { atomicAdd(&(bar)[XB_TMO], 1u); break; } } } } while (0)

struct XcdBarrier {
    unsigned* bar; unsigned x;
    volatile LAS unsigned* st;
};
__device__ __forceinline__ XcdBarrier xcd_barrier_post(unsigned* bar, volatile LAS unsigned* st) {
    XcdBarrier b; b.bar = bar; b.x = xb_xcc_id(); b.st = st;
    if (threadIdx.x == 0) (void)xb_add(&bar[XB_XCNT(b.x)], 1u);
    return b;
}
__device__ __forceinline__ void xcd_barrier_complete(unsigned* bar, unsigned x, unsigned& nloc, unsigned& nx) {
    const unsigned G = gridDim.x * gridDim.y * gridDim.z;
    unsigned sum, cnt, mine, sp = 0u;
    for (;;) {
        sum = 0u; cnt = 0u; mine = 0u;
#pragma unroll
        for (unsigned j = 0; j < 16; ++j) { const unsigned c = xb_ld(&bar[XB_XCNT(j)]); sum += c; cnt += (c > 0u) ? 1u : 0u; mine = (j == x) ? c : mine; }
        if (sum == G) break;
        __builtin_amdgcn_s_sleep(1);
        if ((++sp & 255u) == 0u) { if (xb_ld(&bar[XB_TMO])) break; if (sp > XB_SPIN_CAP) { atomicAdd(&bar[XB_TMO], 1u); break; } }
    }
    nloc = mine > 0u ? mine : 1u; nx = cnt > 0u ? cnt : 1u;
}
__device__ __forceinline__ void xcd_barrier_arrive(const XcdBarrier& b) {
    asm volatile("s_waitcnt vmcnt(0)" ::: "memory");
    __syncthreads();
    if (threadIdx.x == 0) {
        unsigned* bar = b.bar;
        __builtin_amdgcn_s_waitcnt(0);
        unsigned nloc = b.st[0], nx = b.st[1];
        if (nloc == 0u) { xcd_barrier_complete(bar, b.x, nloc, nx); b.st[0] = nloc; b.st[1] = nx; }
        const unsigned old = xb_add(&bar[XB_XSUB(b.x)], 1u);
        const unsigned gen = old / nloc;
        b.st[2] = gen;
        if (old + 1u == (gen + 1u) * nloc) {
            __builtin_amdgcn_fence(__ATOMIC_RELEASE, "agent");
            asm volatile("s_waitcnt vmcnt(0)" ::: "memory");
            const unsigned og = xb_add(&bar[XB_TOP], 1u);
            const unsigned tg = og / nx;
            if (og + 1u == (tg + 1u) * nx) {
#pragma unroll
                for (unsigned j = 0; j < 16; ++j) (void)xb_add(&bar[XB_XGEN(j)], 1u);
            }
        }
    }
    __syncthreads();
}
__device__ __forceinline__ void xcd_barrier_wait(const XcdBarrier& b) {
    if (threadIdx.x == 0) {
        unsigned* bar = b.bar;
        const unsigned gen = b.st[2];
        XB_SPIN(xb_ld(&bar[XB_XGEN(b.x)]) == gen, bar);
        __builtin_amdgcn_fence(__ATOMIC_ACQUIRE, "agent");
        asm volatile("s_waitcnt vmcnt(0)" ::: "memory");
    }
    __syncthreads();
}
__device__ __forceinline__ void xcd_barrier(const XcdBarrier& b) { xcd_barrier_arrive(b); xcd_barrier_wait(b); }

struct BarWait { XcdBarrier b; bool on; __device__ __forceinline__ void operator()() const { if (on) xcd_barrier_wait(b); } };
__device__ __forceinline__ void pair_barrier(unsigned* cnt, unsigned* bar) {
    asm volatile("s_waitcnt vmcnt(0)" ::: "memory");
    __syncthreads();
    if (threadIdx.x == 0) {
        __builtin_amdgcn_fence(__ATOMIC_RELEASE, "agent");
        asm volatile("s_waitcnt vmcnt(0)" ::: "memory");
        (void)xb_add(cnt, 1u);
        XB_SPIN(xb_ld(cnt) < 2u, bar);
        __builtin_amdgcn_fence(__ATOMIC_ACQUIRE, "agent");
        asm volatile("s_waitcnt vmcnt(0)" ::: "memory");
    }
    __syncthreads();
}

struct Frame {
    LAS unsigned char* lds;
    gu32* ctl;
    int tid, lane, wave;
    int vcu, G;
    const void* const* in;
    float* out; unsigned char* ws;
};

using pg8::Unit; using pg8::cvt_pk_bf16; using pg8::MOE_CAP;
constexpr int HALF = pg8::HALF, BM = pg8::BM;
__device__ __forceinline__ unsigned gate8_pack4(float a, float b, float c, float d) {
    unsigned w = 0u;
    w = __builtin_amdgcn_cvt_pk_u8_f32(__builtin_fmaf(a, 256.f, -0.5f), 0u, w); w = __builtin_amdgcn_cvt_pk_u8_f32(__builtin_fmaf(b, 256.f, -0.5f), 1u, w);
    w = __builtin_amdgcn_cvt_pk_u8_f32(__builtin_fmaf(c, 256.f, -0.5f), 2u, w); w = __builtin_amdgcn_cvt_pk_u8_f32(__builtin_fmaf(d, 256.f, -0.5f), 3u, w);
    return w;
}
__device__ __forceinline__ float gate8_q(unsigned w, int j) { return (float)((w >> (8 * j)) & 0xffu) + 0.5f; }
constexpr float ACT_SCALE = 2.f;
constexpr float Y_SCALE = 4.f;
constexpr float MG_SCALE = 4.f;
constexpr float GATE_WSCALE = 64.f;
__device__ __forceinline__ float sigmoid_g8(float z64) { return __builtin_amdgcn_rcpf(1.f + __builtin_amdgcn_exp2f(z64 * (-1.4426950408889634f / GATE_WSCALE))); }
struct EpiGate8 {
    static constexpr bool PERM = true;
    unsigned char* G8;
    __device__ __forceinline__ void operator()(const f32x4 (&acc)[2][2][4][2], const Unit& u, int wr, int wc, int fr, int fq) const {
        const int row0 = u.pm * BM + wr * 64 + fr, col0 = u.pn * BM + wc * 32 + 8 * fq;
#pragma unroll
        for (int ai = 0; ai < 2; ++ai)
#pragma unroll
            for (int m = 0; m < 4; ++m) { unsigned char* rowp = G8 + (size_t)(row0 + ai * HALF + m * 16) * D + col0;
#pragma unroll
                for (int bj = 0; bj < 2; ++bj) { const f32x4 v0 = acc[ai][bj][m][0], v1 = acc[ai][bj][m][1];
                    v2u w; w.x = gate8_pack4(sigmoid_g8(v0[0]), sigmoid_g8(v0[1]), sigmoid_g8(v0[2]), sigmoid_g8(v0[3])); w.y = gate8_pack4(sigmoid_g8(v1[0]), sigmoid_g8(v1[1]), sigmoid_g8(v1[2]), sigmoid_g8(v1[3]));
                    *(v2u*)(rowp + bj * HALF) = w; } }
    }
};
struct EpiP1 {
    static constexpr bool PERM = true;
    bf16* RKV; bf16* REST;
    __device__ __forceinline__ void operator()(const f32x4 (&acc)[2][2][4][2], const Unit& u, int wr, int wc, int fr, int fq) const {
        const int row0 = u.pm * BM + wr * 64 + fr;
        bf16* O = REST; int ldc = NREST, tb = 6;
        if (u.pn < 6) { O = RKV; ldc = NRKV; tb = 0; }
        const int col0 = (u.pn - tb) * BM + wc * 32 + 8 * fq;
#pragma unroll
        for (int ai = 0; ai < 2; ++ai)
#pragma unroll
            for (int m = 0; m < 4; ++m) { bf16* rowp = O + (size_t)(row0 + ai * HALF + m * 16) * ldc + col0;
#pragma unroll
                for (int bj = 0; bj < 2; ++bj) { const f32x4 v0 = acc[ai][bj][m][0], v1 = acc[ai][bj][m][1];
                    v4u w; w.x = cvt_pk_bf16(v0[0], v0[1]); w.y = cvt_pk_bf16(v0[2], v0[3]); w.z = cvt_pk_bf16(v1[0], v1[1]); w.w = cvt_pk_bf16(v1[2], v1[3]);
                    *(v4u*)(rowp + bj * HALF) = w; } }
    }
};
struct EpiMerge2 {
    static constexpr bool PERM = true;
    const unsigned char* GA; const unsigned char* GB; bf16* Mg;
    __device__ __forceinline__ void mid(f32x4 (&acc)[2][2][4][2], const Unit& u, int wr, int wc, int fr, int fq) const {
        const int row0 = u.pm * BM + wr * 64 + fr, col0 = u.pn * BM + wc * 32 + 8 * fq;
#pragma unroll
        for (int ai = 0; ai < 2; ++ai) { v2u ga[4][2], gb[4][2];
#pragma unroll
            for (int m = 0; m < 4; ++m)
#pragma unroll
                for (int bj = 0; bj < 2; ++bj) { const size_t off = (size_t)(row0 + ai * HALF + m * 16) * D + col0 + bj * HALF; ga[m][bj] = *(const v2u*)(GA + off); gb[m][bj] = *(const v2u*)(GB + off); }
#pragma unroll
            for (int m = 0; m < 4; ++m)
#pragma unroll
                for (int bj = 0; bj < 2; ++bj) { const unsigned aw[2] = {ga[m][bj].x, ga[m][bj].y}, bw[2] = {gb[m][bj].x, gb[m][bj].y};
#pragma unroll
                    for (int n = 0; n < 2; ++n)
#pragma unroll
                        for (int j = 0; j < 4; ++j) acc[ai][bj][m][n][j] *= gate8_q(aw[n], j) * __builtin_amdgcn_rcpf(gate8_q(bw[n], j)); }
            asm volatile("" ::: "memory"); }
    }
    __device__ __forceinline__ void operator()(const f32x4 (&acc)[2][2][4][2], const Unit& u, int wr, int wc, int fr, int fq) const {
        const int row0 = u.pm * BM + wr * 64 + fr, col0 = u.pn * BM + wc * 32 + 8 * fq;
        v2u gv[2][4][2];
#pragma unroll
        for (int ai = 0; ai < 2; ++ai)
#pragma unroll
            for (int m = 0; m < 4; ++m)
#pragma unroll
                for (int bj = 0; bj < 2; ++bj) gv[ai][m][bj] = *(const v2u*)(GB + (size_t)(row0 + ai * HALF + m * 16) * D + col0 + bj * HALF);
#pragma unroll
        for (int ai = 0; ai < 2; ++ai)
#pragma unroll
            for (int m = 0; m < 4; ++m) { const size_t off = (size_t)(row0 + ai * HALF + m * 16) * D + col0;
#pragma unroll
                for (int bj = 0; bj < 2; ++bj) { const f32x4 a0 = acc[ai][bj][m][0], a1 = acc[ai][bj][m][1]; const v2u g = gv[ai][m][bj]; constexpr float k = MG_SCALE / 256.f;
                    int w0 = __builtin_amdgcn_cvt_pk_fp8_f32(gate8_q(g.x, 0) * k * a0[0], gate8_q(g.x, 1) * k * a0[1], 0, false); w0 = __builtin_amdgcn_cvt_pk_fp8_f32(gate8_q(g.x, 2) * k * a0[2], gate8_q(g.x, 3) * k * a0[3], w0, true);
                    int w1 = __builtin_amdgcn_cvt_pk_fp8_f32(gate8_q(g.y, 0) * k * a1[0], gate8_q(g.y, 1) * k * a1[1], 0, false); w1 = __builtin_amdgcn_cvt_pk_fp8_f32(gate8_q(g.y, 2) * k * a1[2], gate8_q(g.y, 3) * k * a1[3], w1, true);
                    *(v2u*)((unsigned char*)Mg + off + bj * HALF) = (v2u){(unsigned)w0, (unsigned)w1}; } }
    }
};
struct EpiXmid {
    static constexpr bool PERM = true;
    const float* RINV; bf16* XB; float* SS; unsigned char* XB8;
    __device__ __forceinline__ void operator()(const f32x4 (&acc)[2][2][4][2], const Unit& u, int wr, int wc, int fr, int fq) const {
        const int row0 = u.pm * BM + wr * 64 + fr, col0 = u.pn * BM + wc * 32 + 8 * fq;
#pragma unroll
        for (int ai = 0; ai < 2; ++ai) { v4u xv[4][2]; float ri[4];
#pragma unroll
            for (int m = 0; m < 4; ++m) { ri[m] = RINV[row0 + ai * HALF + m * 16];
#pragma unroll
                for (int bj = 0; bj < 2; ++bj) xv[m][bj] = *(const v4u*)(XB + (size_t)(row0 + ai * HALF + m * 16) * D + col0 + bj * HALF); }
#pragma unroll
            for (int m = 0; m < 4; ++m) { const int row = row0 + ai * HALF + m * 16; const size_t off = (size_t)row * D + col0; float ss = 0.f; const float r = ri[m];
#pragma unroll
                for (int bj = 0; bj < 2; ++bj) { const v4u x = xv[m][bj];
                    constexpr float XS = 1.f / (MG_SCALE * GATE_WSCALE);
                    const f32x4 v0 = (f32x4){bflo(x.x), bfhi(x.x), bflo(x.y), bfhi(x.y)} * r + acc[ai][bj][m][0] * XS, v1 = (f32x4){bflo(x.z), bfhi(x.z), bflo(x.w), bfhi(x.w)} * r + acc[ai][bj][m][1] * XS;
                    ss += ((v0[0] * v0[0] + v0[1] * v0[1]) + (v0[2] * v0[2] + v0[3] * v0[3])) + ((v1[0] * v1[0] + v1[1] * v1[1]) + (v1[2] * v1[2] + v1[3] * v1[3]));
                    v4u w; w.x = cvt_pk_bf16(v0[0], v0[1]); w.y = cvt_pk_bf16(v0[2], v0[3]); w.z = cvt_pk_bf16(v1[0], v1[1]); w.w = cvt_pk_bf16(v1[2], v1[3]);
                    *(v4u*)(XB + off + bj * HALF) = w;
                    int q0 = __builtin_amdgcn_cvt_pk_fp8_f32(v0[0], v0[1], 0, false); q0 = __builtin_amdgcn_cvt_pk_fp8_f32(v0[2], v0[3], q0, true);
                    int q1 = __builtin_amdgcn_cvt_pk_fp8_f32(v1[0], v1[1], 0, false); q1 = __builtin_amdgcn_cvt_pk_fp8_f32(v1[2], v1[3], q1, true);
                    *(v2u*)(XB8 + off + bj * HALF) = (v2u){(unsigned)q0, (unsigned)q1}; }
                ss += __shfl_xor(ss, 16); ss += __shfl_xor(ss, 32);
                if (fq == 0) atomicAdd(SS + row, ss); } }
    }
};
struct EpiQ {
    static constexpr bool PERM = false;
    bf16* Q; const float* sq; const float* cs; const float* sn;
    __device__ __forceinline__ void operator()(const f32x4 (&acc)[2][2][4][2], const Unit& u, int wr, int wc, int fr, int fq) const {
        const int row0 = u.pm * BM + wr * 64 + fr;
#pragma unroll
        for (int ai = 0; ai < 2; ++ai) { float sv_[4]; f32x4 cv[4], sv[4];
#pragma unroll
            for (int m = 0; m < 4; ++m) { const int row = row0 + ai * HALF + m * 16; sv_[m] = sq[row]; cv[m] = *(const f32x4*)(cs + (size_t)row * 16 + 4 * fq); sv[m] = *(const f32x4*)(sn + (size_t)row * 16 + 4 * fq); }
#pragma unroll
            for (int m = 0; m < 4; ++m) { const int row = row0 + ai * HALF + m * 16; const float s = sv_[m] * QSCALE;
#pragma unroll
                for (int bj = 0; bj < 2; ++bj) { const int g32 = u.pn * 8 + bj * 4 + wc; const int col = g32 * 32 + 4 * fq;
                    f32x4 t1 = acc[ai][bj][m][0] * s, t2 = acc[ai][bj][m][1] * s;
                    if (g32 % 3 == 2) { const f32x4 o1 = t1 * cv[m] - t2 * sv[m], o2 = t2 * cv[m] + t1 * sv[m]; t1 = o1; t2 = o2; }
                    v2u w1, w2; w1.x = cvt_pk_bf16(t1[0], t1[1]); w1.y = cvt_pk_bf16(t1[2], t1[3]); w2.x = cvt_pk_bf16(t2[0], t2[1]); w2.y = cvt_pk_bf16(t2[2], t2[3]);
                    *(v2u*)(Q + (size_t)row * QPITCH + col) = w1; *(v2u*)(Q + (size_t)row * QPITCH + col + 16) = w2; } } }
    }
};
struct EpiKn {
    static constexpr bool PERM = true;
    bf16* Kb; const float* skv;
    __device__ __forceinline__ void operator()(const f32x4 (&acc)[2][2][4][2], const Unit& u, int wr, int wc, int fr, int fq) const {
        const int row0 = u.pm * BM + wr * 64 + fr; float sc_[2][4];
#pragma unroll
        for (int ai = 0; ai < 2; ++ai)
#pragma unroll
            for (int m = 0; m < 4; ++m) sc_[ai][m] = skv[row0 + ai * HALF + m * 16];
#pragma unroll
        for (int ai = 0; ai < 2; ++ai)
#pragma unroll
            for (int m = 0; m < 4; ++m) { const int row = row0 + ai * HALF + m * 16; const float s = sc_[ai][m];
#pragma unroll
                for (int bj = 0; bj < 2; ++bj) { const int c = u.pn * BM + bj * HALF + wc * 32 + 8 * fq;
                    const f32x4 v0 = acc[ai][bj][m][0] * s, v1 = acc[ai][bj][m][1] * s;
                    v4u w; w.x = cvt_pk_bf16(v0[0], v0[1]); w.y = cvt_pk_bf16(v0[2], v0[3]); w.z = cvt_pk_bf16(v1[0], v1[1]); w.w = cvt_pk_bf16(v1[2], v1[3]);
                    *(v4u*)(Kb + (size_t)row * 1024 + c) = w; } }
    }
};
struct EpiLogits {
    static constexpr bool PERM = false;
    float* L; const float* SS;
    __device__ __forceinline__ void operator()(const f32x4 (&acc)[2][2][4][2], const Unit& u, int wr, int wc, int fr, int fq) const {
        if (u.pn != 0 || wc >= 2) return;
        const int row0 = u.pm * BM + wr * 64 + fr; float sc_[2][4];
#pragma unroll
        for (int ai = 0; ai < 2; ++ai)
#pragma unroll
            for (int m = 0; m < 4; ++m) sc_[ai][m] = 1.f / sqrtf(SS[row0 + ai * HALF + m * 16] * (1.f / D) + NORM_EPS);
#pragma unroll
        for (int ai = 0; ai < 2; ++ai)
#pragma unroll
            for (int m = 0; m < 4; ++m)
#pragma unroll
                for (int n = 0; n < 2; ++n) { const int row = row0 + ai * HALF + m * 16; const float rs = sc_[ai][m]; *(f32x4*)(L + (size_t)row * 64 + wc * 32 + n * 16 + 4 * fq) = acc[ai][0][m][n] * rs; }
    }
};
struct EpiSwiglu {
    static constexpr bool PERM = true;
    bf16* ACT; const float* rsb;
    __device__ __forceinline__ void operator()(const f32x4 (&acc)[2][2][4][2], const Unit& u, int wr, int wc, int fr, int fq) const {
        const int row0 = u.pm * BM + wr * 64 + fr, col0 = u.pn * HALF + wc * 32 + 8 * fq; float sc_[2][4];
#pragma unroll
        for (int ai = 0; ai < 2; ++ai)
#pragma unroll
            for (int m = 0; m < 4; ++m) sc_[ai][m] = rsb[u.gb + wr * 64 + fr + ai * HALF + m * 16];
#pragma unroll
        for (int ai = 0; ai < 2; ++ai)
#pragma unroll
            for (int m = 0; m < 4; ++m) { float r[8]; const float rs = sc_[ai][m] * (1.f / GATE_WSCALE);
#pragma unroll
                for (int n = 0; n < 2; ++n)
#pragma unroll
                    for (int j = 0; j < 4; ++j) { const float gt = acc[ai][0][m][n][j] * rs, up = acc[ai][1][m][n][j] * (rs * ACT_SCALE); r[n * 4 + j] = gt * sigmoidf_(gt) * up; }
                int w0 = __builtin_amdgcn_cvt_pk_fp8_f32(r[0], r[1], 0, false); w0 = __builtin_amdgcn_cvt_pk_fp8_f32(r[2], r[3], w0, true); int w1 = __builtin_amdgcn_cvt_pk_fp8_f32(r[4], r[5], 0, false); w1 = __builtin_amdgcn_cvt_pk_fp8_f32(r[6], r[7], w1, true);
                *(v2u*)((unsigned char*)ACT + (size_t)(row0 + ai * HALF + m * 16) * DEXP + col0) = (v2u){(unsigned)w0, (unsigned)w1}; }
    }
};
struct EpiDown {
    static constexpr bool PERM = true;
    bf16* Y; const float* wbuf;
    __device__ __forceinline__ void operator()(const f32x4 (&acc)[2][2][4][2], const Unit& u, int wr, int wc, int fr, int fq) const {
        const int row0 = u.pm * BM + wr * 64 + fr, col0 = u.pn * BM + wc * 32 + 8 * fq; float sc_[2][4];
#pragma unroll
        for (int ai = 0; ai < 2; ++ai)
#pragma unroll
            for (int m = 0; m < 4; ++m) sc_[ai][m] = wbuf[u.gb + wr * 64 + fr + ai * HALF + m * 16];
#pragma unroll
        for (int ai = 0; ai < 2; ++ai)
#pragma unroll
            for (int m = 0; m < 4; ++m) { const int row = row0 + ai * HALF + m * 16; const float s = sc_[ai][m] * (Y_SCALE / (GATE_WSCALE * ACT_SCALE));
#pragma unroll
                for (int bj = 0; bj < 2; ++bj) { const f32x4 v0 = acc[ai][bj][m][0] * s, v1 = acc[ai][bj][m][1] * s;
                    int w0 = __builtin_amdgcn_cvt_pk_fp8_f32(v0[0], v0[1], 0, false); w0 = __builtin_amdgcn_cvt_pk_fp8_f32(v0[2], v0[3], w0, true);
                    int w1 = __builtin_amdgcn_cvt_pk_fp8_f32(v1[0], v1[1], 0, false); w1 = __builtin_amdgcn_cvt_pk_fp8_f32(v1[2], v1[3], w1, true);
                    *(v2u*)((unsigned char*)Y + (size_t)row * D + col0 + bj * HALF) = (v2u){(unsigned)w0, (unsigned)w1}; } }
    }
};

template <bool F8 = false>
__device__ __forceinline__ void p0_transpose_item(const float* W, int ldw, int k0, int n0, bf16* WT, int ldt, int dst_row0, const float* kscale, LAS float* scr, int lane) {
    f32x4 ld[8];
#pragma unroll
    for (int i = 0; i < 8; ++i) ld[i] = *(const f32x4*)(W + (size_t)(k0 + (lane >> 3) + 8 * i) * ldw + n0 + 4 * (lane & 7));
    float ksv[8];
#pragma unroll
    for (int i = 0; i < 8; ++i) ksv[i] = (kscale ? kscale[k0 + (lane >> 3) + 8 * i] : 1.f) * (F8 ? GATE_WSCALE : 1.f);
    asm volatile("" : "+v"(ksv[0]), "+v"(ksv[1]), "+v"(ksv[2]), "+v"(ksv[3]), "+v"(ksv[4]), "+v"(ksv[5]), "+v"(ksv[6]), "+v"(ksv[7]));
#pragma unroll
    for (int i = 0; i < 8; ++i) { const int kk = (lane >> 3) + 8 * i; const float s = ksv[i]; LAS float* d = scr + kk * 33 + 4 * (lane & 7); d[0] = ld[i].x * s; d[1] = ld[i].y * s; d[2] = ld[i].z * s; d[3] = ld[i].w * s; }
    LDS_WAIT(); asm volatile("" ::: "memory");
    const int c = lane & 7;
#pragma unroll
    for (int j = 0; j < 4; ++j) { const int n = (lane >> 3) + 8 * j; const LAS float* s = scr + (8 * c) * 33 + n;
        if constexpr (F8) { v2u o; o.x = (unsigned)__builtin_amdgcn_cvt_pk_fp8_f32(s[0 * 33], s[1 * 33], 0, false); o.x = (unsigned)__builtin_amdgcn_cvt_pk_fp8_f32(s[2 * 33], s[3 * 33], (int)o.x, true);
            o.y = (unsigned)__builtin_amdgcn_cvt_pk_fp8_f32(s[4 * 33], s[5 * 33], 0, false); o.y = (unsigned)__builtin_amdgcn_cvt_pk_fp8_f32(s[6 * 33], s[7 * 33], (int)o.y, true);
            *(v2u*)((unsigned char*)WT + (size_t)(dst_row0 + n) * ldt + k0 + 8 * c) = o; }
        else { v4u o; o.x = pk2(s[0 * 33], s[1 * 33]); o.y = pk2(s[2 * 33], s[3 * 33]); o.z = pk2(s[4 * 33], s[5 * 33]); o.w = pk2(s[6 * 33], s[7 * 33]);
        *(v4u*)(WT + (size_t)(dst_row0 + n) * ldt + k0 + 8 * c) = o; } }
    LDS_WAIT(); asm volatile("" ::: "memory");
}
struct P0In { const float *ffn_g, *x, *mix_g, *w_in, *w_up, *a_up, *g_up, *g_qa, *w_q_up, *g_kva, *w_kv_up, *w_br, *w_bm, *w_out, *w_group, *w_router, *w_gu, *w_down; const int* pos; };
__device__ __forceinline__ void p0_prologue(const Frame& F, const P0In& I) {
    unsigned char* ws = F.ws;
    LAS float* scr = (LAS float*)(F.lds + F.wave * 16384);
    const int gw = F.vcu * NWAVES + F.wave, NGW = F.G * NWAVES, lane = F.lane;
    constexpr int I_IN = 16 * 141, I_Q = 6 * 24, I_KV = 4 * 32, I_BR = 8 * 32, I_O = 16 * 32, I_LW = 16, I_LG = 32;
    constexpr int NITEMS = I_IN + I_Q + I_KV + 2 * I_BR + I_O + 2 * I_LW + I_LG;
    for (int it = gw; it < NITEMS; it += NGW) {
        int r = it;
        if (r < I_IN) { const int kb = r / 141, nb = r % 141, n0 = nb * 32;
            const int dst = n0 < 1792 ? 2048 + n0 : (n0 < 2464 ? 3840 + (n0 - 1792) : n0 - 2464);
            if (n0 < 2464) p0_transpose_item<false>(I.w_in, IN_COLS, kb * 64, n0, (bf16*)(ws + WS_WIN), D, dst, I.mix_g, scr, lane);
            else p0_transpose_item<true>(I.w_in, IN_COLS, kb * 64, n0, (bf16*)(ws + WS_WIN8), D, dst, I.mix_g, scr, lane);
            continue; } r -= I_IN;
        if (r < I_Q) { const int kb = r / 24, nb = r % 24; p0_transpose_item(I.w_q_up, 768, kb * 64, nb * 32, (bf16*)(ws + WS_WQ), QL, nb * 32, I.g_qa, scr, lane); continue; } r -= I_Q;
        if (r < I_KV) { const int kb = r / 32, nb = r % 32, n0 = nb * 32, h = n0 >> 7, j = n0 & 127; const int dst = j < 64 ? h * 64 + j : 512 + h * 64 + (j - 64);
            p0_transpose_item(I.w_kv_up, 1024, kb * 64, n0, (bf16*)(ws + WS_WKN), KVL, dst, I.g_kva, scr, lane); continue; } r -= I_KV;
        if (r < I_BR) { const int kb = r / 32, nb = r % 32; p0_transpose_item(I.w_br, D, kb * 64, nb * 32, (bf16*)(ws + WS_WBR), D, nb * 32, nullptr, scr, lane); continue; } r -= I_BR;
        if (r < I_BR) { const int kb = r / 32, nb = r % 32; p0_transpose_item(I.w_bm, D, kb * 64, nb * 32, (bf16*)(ws + WS_WBR) + RWD, D, nb * 32, nullptr, scr, lane); continue; } r -= I_BR;
        if (r < I_O) { const int kb = r / 32, nb = r % 32; p0_transpose_item<true>(I.w_out, D, kb * 64, nb * 32, (bf16*)(ws + WS_WO), D, nb * 32, nullptr, scr, lane); continue; } r -= I_O;
        if (r < I_LW) { p0_transpose_item(I.w_up, RWD, 0, r * 32, (bf16*)(ws + WS_LWUP), 64, r * 32, nullptr, scr, lane); continue; } r -= I_LW;
        if (r < I_LW) { p0_transpose_item(I.a_up, RWD, 0, r * 32, (bf16*)(ws + WS_LAUP), 64, r * 32, nullptr, scr, lane); continue; } r -= I_LW;
        { const int kb = r / 16, nb = r % 16; p0_transpose_item(I.g_up, RWD, kb * 64, nb * 32, (bf16*)(ws + WS_LGUP), 128, nb * 32, nullptr, scr, lane); }
    }
    const int gt = F.vcu * (NWAVES * 64) + F.tid, NGT = F.G * NWAVES * 64;
    { bf16* WR = (bf16*)(ws + WS_WR);
      for (int i = gt; i < 256 * D; i += NGT) { const int j = i >> 10, k = i & 1023; float v = 0.f; if (j < 4) v = I.w_group[k * 4 + j]; else if (j < 36) v = I.w_router[k * 32 + (j - 4)]; WR[i] = (bf16)f2bf(v * I.ffn_g[k]); }
      bf16* WP = (bf16*)(ws + WS_WIN) + (size_t)IN_COLS * D;
      for (int i = gt; i < 96 * D; i += NGT) WP[i] = 0; }
    { float* CS = (float*)(ws + WS_COS); float* SN = (float*)(ws + WS_SIN);
      for (int i = gt; i < M * 16; i += NGT) { const int m = i >> 4, j = i & 15;
          const float inv_freq = exp2f(-(float)j * (13.287712379549449f / 16.f));
          const float ang = (float)I.pos[m] * inv_freq;
          const double rev = (double)ang * 0.15915494309189535; const double fr = rev - __builtin_rint(rev);
          CS[i] = __builtin_amdgcn_cosf((float)fr); SN[i] = __builtin_amdgcn_sinf((float)fr); } }
    { v4u* TB = (v4u*)(ws + WS_TOK2); for (int i = gt; i < 32 * MOE_CAP / 4; i += NGT) TB[i] = (v4u){0u, 0u, 0u, 0u}; }
    { bf16* XN = (bf16*)(ws + WS_XN); float* RINV = (float*)(ws + WS_RINV);
      for (int m = gw; m < M; m += NGW) {
          const f32x4* xr = (const f32x4*)(I.x + (size_t)m * D) + lane;
          f32x4 v[4]; float s = 0.f;
#pragma unroll
          for (int j = 0; j < 4; ++j) { v[j] = xr[64 * j]; s += (v[j].x * v[j].x + v[j].y * v[j].y) + (v[j].z * v[j].z + v[j].w * v[j].w); }
          const float rq = sqrtf(wave_sum(s) * (1.f / D) + NORM_EPS), rs = 1.f / rq; if (lane == 0) RINV[m] = rq;
          unsigned long long* o8 = (unsigned long long*)(XN + (size_t)m * D) + lane;
#pragma unroll
          for (int j = 0; j < 4; ++j) o8[64 * j] = (unsigned long long)pk2(v[j].x * rs, v[j].y * rs) | ((unsigned long long)pk2(v[j].z * rs, v[j].w * rs) << 32);
          unsigned* o4 = (unsigned*)(ws + WS_XN8 + (size_t)m * D) + lane;
#pragma unroll
          for (int j = 0; j < 4; ++j) { int w = __builtin_amdgcn_cvt_pk_fp8_f32(v[j].x * rs, v[j].y * rs, 0, false); w = __builtin_amdgcn_cvt_pk_fp8_f32(v[j].z * rs, v[j].w * rs, w, true); o4[64 * j] = (unsigned)w; }
      } }
}

__device__ __forceinline__ float dpp_add_xor1(float v) { return v + __builtin_bit_cast(float, __builtin_amdgcn_update_dpp(0, __builtin_bit_cast(int, v), 0xB1, 0xF, 0xF, true)); }
__device__ __forceinline__ float dpp_add_xor2(float v) { return v + __builtin_bit_cast(float, __builtin_amdgcn_update_dpp(0, __builtin_bit_cast(int, v), 0x4E, 0xF, 0xF, true)); }
__device__ __forceinline__ float dpp_add_hmir(float v) { return v + __builtin_bit_cast(float, __builtin_amdgcn_update_dpp(0, __builtin_bit_cast(int, v), 0x141, 0xF, 0xF, true)); }
__device__ __forceinline__ float red8(float v) { return dpp_add_hmir(dpp_add_xor2(dpp_add_xor1(v))); }
__device__ __forceinline__ float dpp_add_mir(float v) { return v + __builtin_bit_cast(float, __builtin_amdgcn_update_dpp(0, __builtin_bit_cast(int, v), 0x140, 0xF, 0xF, true)); }
__device__ __forceinline__ float red16(float v) { return dpp_add_mir(red8(v)); }
struct P2In { const float *mu, *w0, *a0; };
template <int KD> __device__ __forceinline__ void lora_load(bf16x8 (&wf)[KD / 32][4], const bf16* Wt, int wave, int lane) {
    const int i = lane & 15, q = lane >> 4;
#pragma unroll
    for (int ks = 0; ks < KD / 32; ++ks)
#pragma unroll
        for (int cb = 0; cb < 4; ++cb) wf[ks][cb] = *(const bf16x8*)(Wt + (size_t)(64 * wave + 16 * cb + i) * KD + 32 * ks + 8 * q);
}
template <int KD> __device__ __forceinline__ void lora_mma(f32x4 (&acc)[4][4], const bf16x8 (&wf)[KD / 32][4], const LAS bf16* act, int apitch, int wave, int lane) {
    const int i = lane & 15, q = lane >> 4;
#pragma unroll
    for (int cb = 0; cb < 4; ++cb)
#pragma unroll
        for (int tb = 0; tb < 4; ++tb) acc[cb][tb] = (f32x4){0.f, 0.f, 0.f, 0.f};
#pragma unroll
    for (int ks = 0; ks < KD / 32; ++ks) {
        bf16x8 bfr[4];
#pragma unroll
        for (int tb = 0; tb < 4; ++tb) bfr[tb] = *(const LAS bf16x8*)(act + (16 * tb + i) * apitch + 32 * ks + 8 * q);
#pragma unroll
        for (int cb = 0; cb < 4; ++cb) { const bf16x8 afr = wf[ks][cb];
#pragma unroll
            for (int tb = 0; tb < 4; ++tb) acc[cb][tb] = __builtin_amdgcn_mfma_f32_16x16x32_bf16(afr, bfr[tb], acc[cb][tb], 0, 0, 0); }
    }
}
__device__ __forceinline__ void p2_prep(const Frame& F, const P2In& I, const XcdBarrier wbar, const bool wb) {
    unsigned char* ws = F.ws;
    const bf16* REST = (const bf16*)(ws + WS_REST);
    float* DEC = (float*)((unsigned char*)F.out + OUT_DEC); bf16* AA = (bf16*)((unsigned char*)F.out + OUT_AA); bf16* GG = (bf16*)((unsigned char*)F.out + OUT_G);
    LAS bf16* Aw = (LAS bf16*)(F.lds); LAS bf16* Aa = (LAS bf16*)(F.lds + 9216); LAS bf16* Ag = (LAS bf16*)(F.lds + 18432);
    const int lane = F.lane, wave = F.wave, i16 = lane & 15, q = lane >> 4;
    bf16x8 wfw[2][4], wfa[2][4];
    lora_load<64>(wfw, (const bf16*)(ws + WS_LWUP), wave, lane); lora_load<64>(wfa, (const bf16*)(ws + WS_LAUP), wave, lane);
    if (wb) xcd_barrier_wait(wbar);
    for (int tile = F.vcu; tile < M / 64; tile += F.G) {
        const int m0 = tile * 64;
        for (int c = F.tid; c < 2048; c += NWAVES * 64) { const int tok = c >> 5, ch = (c & 31) * 8; const int m = m0 + tok;
            const bf16* cur = REST + (size_t)m * NREST + ch;
            const v4u cv = *(const v4u*)cur; v4u pv = (v4u){0u, 0u, 0u, 0u}; if ((m & (SEQ - 1)) != 0) pv = *(const v4u*)(cur - NREST);
            const f32x4 mu0 = *(const f32x4*)(I.mu + C_WD + ch), mu1 = *(const f32x4*)(I.mu + C_WD + ch + 4);
            float z[8]; const unsigned cw[4] = {cv.x, cv.y, cv.z, cv.w}, pw[4] = {pv.x, pv.y, pv.z, pv.w}; const float muv[8] = {mu0.x, mu0.y, mu0.z, mu0.w, mu1.x, mu1.y, mu1.z, mu1.w};
#pragma unroll
            for (int j = 0; j < 4; ++j) { const float c0 = bflo(cw[j]), c1 = bfhi(cw[j]), p0 = bflo(pw[j]), p1 = bfhi(pw[j]); z[2 * j] = c0 + (p0 - c0) * muv[2 * j]; z[2 * j + 1] = c1 + (p1 - c1) * muv[2 * j + 1]; }
            LAS bf16* dst;
            if (ch < 64) {
#pragma unroll
                for (int j = 0; j < 8; ++j) { const float e = __expf(2.f * z[j]); z[j] = 1.f - 2.f * __builtin_amdgcn_rcpf(e + 1.f); }
                dst = Aw + tok * 72 + ch;
            } else if (ch < 128) dst = Aa + tok * 72 + (ch - 64);
            else {
#pragma unroll
                for (int j = 0; j < 8; ++j) z[j] = sigmoidf_(z[j]);
                dst = Ag + tok * 136 + (ch - 128);
            }
            v4u o; o.x = pk2(z[0], z[1]); o.y = pk2(z[2], z[3]); o.z = pk2(z[4], z[5]); o.w = pk2(z[6], z[7]);
            *(LAS v4u*)dst = o;
        }
        __syncthreads();
        f32x4 acc[4][4];
        f32x4 w0v[4];
#pragma unroll
        for (int cb = 0; cb < 4; ++cb) w0v[cb] = *(const f32x4*)(I.w0 + 64 * wave + 16 * cb + 4 * q);
        asm volatile("" : "+v"(w0v[0]), "+v"(w0v[1]), "+v"(w0v[2]), "+v"(w0v[3]));
        lora_mma<64>(acc, wfw, Aw, 72, wave, lane);
#pragma unroll
        for (int cb = 0; cb < 4; ++cb) { const int ch = 64 * wave + 16 * cb + 4 * q; const f32x4 w0 = w0v[cb];
#pragma unroll
            for (int tb = 0; tb < 4; ++tb) { const int m = m0 + 16 * tb + i16; f32x4 o;
#pragma unroll
                for (int j = 0; j < 4; ++j) { float x = -0.6065306597126334f * sigmoidf_(w0[j] + acc[cb][tb][j]);
                    x += __builtin_bit_cast(float, __builtin_amdgcn_update_dpp(0, __builtin_bit_cast(int, x), 0x111, 0xF, 0xF, true)); x += __builtin_bit_cast(float, __builtin_amdgcn_update_dpp(0, __builtin_bit_cast(int, x), 0x112, 0xF, 0xF, true));
                    x += __builtin_bit_cast(float, __builtin_amdgcn_update_dpp(0, __builtin_bit_cast(int, x), 0x114, 0xF, 0xF, true)); x += __builtin_bit_cast(float, __builtin_amdgcn_update_dpp(0, __builtin_bit_cast(int, x), 0x118, 0xF, 0xF, true));
                    o[j] = x; }
                *(f32x4*)(DEC + (size_t)m * RWD + ch) = o; } }
        f32x4 a0v[4];
#pragma unroll
        for (int cb = 0; cb < 4; ++cb) a0v[cb] = *(const f32x4*)(I.a0 + 64 * wave + 16 * cb + 4 * q);
        asm volatile("" : "+v"(a0v[0]), "+v"(a0v[1]), "+v"(a0v[2]), "+v"(a0v[3]));
        lora_mma<64>(acc, wfa, Aa, 72, wave, lane);
#pragma unroll
        for (int cb = 0; cb < 4; ++cb) { const int ch = 64 * wave + 16 * cb + 4 * q; const f32x4 a0 = a0v[cb];
#pragma unroll
            for (int tb = 0; tb < 4; ++tb) { const int m = m0 + 16 * tb + i16; v2u o;
                o.x = pk2(sigmoidf_(a0[0] + acc[cb][tb][0]), sigmoidf_(a0[1] + acc[cb][tb][1])); o.y = pk2(sigmoidf_(a0[2] + acc[cb][tb][2]), sigmoidf_(a0[3] + acc[cb][tb][3]));
                *(v2u*)(AA + (size_t)m * RWD + ch) = o; } }
        {
          const bf16* Wg = (const bf16*)(ws + WS_LGUP);
#pragma unroll
          for (int kh = 0; kh < 2; ++kh) { bf16x8 wg[2][4];
#pragma unroll
              for (int ks = 0; ks < 2; ++ks)
#pragma unroll
                  for (int cb = 0; cb < 4; ++cb) wg[ks][cb] = *(const bf16x8*)(Wg + (size_t)(64 * wave + 16 * cb + i16) * 128 + 64 * kh + 32 * ks + 8 * q);
              asm volatile("" : "+v"(wg[0][0]), "+v"(wg[0][1]), "+v"(wg[0][2]), "+v"(wg[0][3]), "+v"(wg[1][0]), "+v"(wg[1][1]), "+v"(wg[1][2]), "+v"(wg[1][3]));
#pragma unroll
              for (int ks = 0; ks < 2; ++ks) { bf16x8 bfr[4];
#pragma unroll
                  for (int tb = 0; tb < 4; ++tb) bfr[tb] = *(const LAS bf16x8*)(Ag + (16 * tb + i16) * 136 + 64 * kh + 32 * ks + 8 * q);
#pragma unroll
                  for (int cb = 0; cb < 4; ++cb)
#pragma unroll
                      for (int tb = 0; tb < 4; ++tb) acc[cb][tb] = __builtin_amdgcn_mfma_f32_16x16x32_bf16(wg[ks][cb], bfr[tb], (kh == 0 && ks == 0) ? (f32x4){0.f, 0.f, 0.f, 0.f} : acc[cb][tb], 0, 0, 0); } } }
#pragma unroll
        for (int cb = 0; cb < 4; ++cb) { const int ch = 64 * wave + 16 * cb + 4 * q;
#pragma unroll
            for (int tb = 0; tb < 4; ++tb) { const int m = m0 + 16 * tb + i16; v2u o; o.x = pk2(acc[cb][tb][0], acc[cb][tb][1]); o.y = pk2(acc[cb][tb][2], acc[cb][tb][3]);
                *(v2u*)(GG + (size_t)m * RWD + ch) = o; } }
        __syncthreads();
    }
    float* SQ = (float*)(ws + WS_SQ); float* SKV = (float*)(ws + WS_SKV); const float* CS = (const float*)(ws + WS_COS); const float* SN = (const float*)(ws + WS_SIN);
    bf16* KR = (bf16*)(ws + WS_KROPE);
    const int gw = F.vcu * NWAVES + wave, NGW = F.G * NWAVES, g4 = lane >> 4, l16 = lane & 15;
    for (int mb = gw * 4; mb < M; mb += NGW * 4) {
        const int m = mb + g4; const bf16* rowp = REST + (size_t)m * NREST;
        v4u q[3], k[2];
#pragma unroll
        for (int j = 0; j < 3; ++j) q[j] = *(const v4u*)(rowp + R_Q + (l16 + 16 * j) * 8);
#pragma unroll
        for (int j = 0; j < 2; ++j) k[j] = *(const v4u*)(rowp + R_KV + (l16 + 16 * j) * 8);
        const float t1 = bflo((unsigned)rowp[R_KR + l16]), t2 = bflo((unsigned)rowp[R_KR + 16 + l16]); const float c = CS[(size_t)m * 16 + l16], sn = SN[(size_t)m * 16 + l16];
        float s1 = 0.f, s2 = 0.f;
#pragma unroll
        for (int j = 0; j < 3; ++j) { const unsigned w[4] = {q[j].x, q[j].y, q[j].z, q[j].w};
#pragma unroll
            for (int e = 0; e < 4; ++e) { const float a = bflo(w[e]), b = bfhi(w[e]); s1 += a * a + b * b; } }
#pragma unroll
        for (int j = 0; j < 2; ++j) { const unsigned w[4] = {k[j].x, k[j].y, k[j].z, k[j].w};
#pragma unroll
            for (int e = 0; e < 4; ++e) { const float a = bflo(w[e]), b = bfhi(w[e]); s2 += a * a + b * b; } }
        s1 = red16(s1); s2 = red16(s2);
        if (l16 == 0) { SQ[m] = 1.f / sqrtf(s1 * (1.f / QL) + NORM_EPS); SKV[m] = 1.f / sqrtf(s2 * (1.f / KVL) + NORM_EPS); }
        KR[(size_t)m * 32 + l16] = (bf16)f2bf(t1 * c - t2 * sn); KR[(size_t)m * 32 + 16 + l16] = (bf16)f2bf(t2 * c + t1 * sn);
    }
}

struct ScanIn { const float *mu, *k_k, *k_a, *r_k, *gn_w, *gn_b; };
typedef short bf16x4s __attribute__((ext_vector_type(4)));
constexpr int SC_T = 32;
constexpr int TP = 44;
constexpr int L_KT = 0, L_RT = 4608, L_KH = 9216, L_NBH = 13824, L_KHT = 18432, L_NBHT = L_KHT + 64 * TP * 2, L_VV = L_NBHT + 64 * TP * 2, L_M1T = L_VV + 64 * TP * 2, L_M2T = L_M1T + 1536, L_N2T = L_M2T + 1536, L_NT = L_N2T + 1536, L_GC = L_NT + 2048,
              L_XT = L_GC + 512, L_ZTT = L_XT + 16896, L_QT = L_ZTT + 128 * TP * 2, L_ZK = L_QT + 4608, L_S0 = L_ZK + 4608, L_Y1T = L_S0 + 18432, L_LW = L_Y1T;
constexpr int L_KHT2 = L_Y1T + 32 * 68 * 4, L_GC2 = L_KHT2 + 3 * 64 * TP * 2;
constexpr int L_ZK2 = L_M1T;
constexpr int L_Y1T2 = L_S0 + 9216;
constexpr int L_ZTT2 = MISC_OFF + 1024;
static_assert(L_NBHT == L_KHT + 64 * TP * 2 && L_VV == L_NBHT + 64 * TP * 2 && L_GC2 + 512 <= RING_BYTES && L_M1T + 4608 <= L_NT && 32 * 68 * 4 <= 9216 && L_ZTT2 + 128 * TP * 2 <= LDS_BYTES, "scan LDS map");
__device__ __forceinline__ f32x4 mfma16(bf16x4s a, bf16x4s b, f32x4 c) { return __builtin_amdgcn_mfma_f32_16x16x16bf16_1k(a, b, c, 0, 0, 0); }
__device__ __forceinline__ f32x4 mfma32(bf16x8 a, bf16x8 b, f32x4 c) { return __builtin_amdgcn_mfma_f32_16x16x32_bf16(a, b, c, 0, 0, 0); }
__device__ __forceinline__ void scan_phase(const Frame& F, const ScanIn& I, int bh) {
    unsigned char* ws = F.ws; LAS unsigned char* lds = F.lds;
    const int b = bh >> 3, h = bh & 7, tid = F.tid, lane = F.lane, wave = F.wave, l15_ = lane & 15, q4_ = lane >> 4;
    const bf16* RKV = (const bf16*)(ws + WS_RKV);
    const float* DEC = (const float*)((unsigned char*)F.out + OUT_DEC); const bf16* AA = (const bf16*)((unsigned char*)F.out + OUT_AA); const bf16* GG = (const bf16*)((unsigned char*)F.out + OUT_G);
    bf16* YRW = (bf16*)(ws + WS_YCAT);
    const int tt = tid >> 4, c4 = (tid & 15) * 4, hc = h * HD + c4;
    f32x4 mu_r = *(const f32x4*)(I.mu + C_R + hc), mu_k = *(const f32x4*)(I.mu + C_K + hc), mu_v = *(const f32x4*)(I.mu + C_V + hc);
    f32x4 kk_k = *(const f32x4*)(I.k_k + hc), kk_a = *(const f32x4*)(I.k_a + hc), rr_k = *(const f32x4*)(I.r_k + hc);
    f32x4 gnw = *(const f32x4*)(I.gn_w + hc), gnb = *(const f32x4*)(I.gn_b + hc);
    asm volatile("" : "+v"(mu_r), "+v"(mu_k), "+v"(mu_v), "+v"(kk_k), "+v"(kk_a), "+v"(rr_k), "+v"(gnw), "+v"(gnb));
    for (int i = tid; i < 2 * 64 * 72 / 2; i += NWAVES * 64) ((LAS unsigned*)(lds + L_S0))[i] = 0u;
    int pp = 0;
    f32x4 Sacc[4];
#pragma unroll
    for (int kb = 0; kb < 4; ++kb) Sacc[kb] = (f32x4){0.f, 0.f, 0.f, 0.f};
    v2u rc, rp, kc, kpv, vc, vp, av; f32x4 cum4, cprev4;
#define SC_BAR() asm volatile("s_waitcnt lgkmcnt(0)\n\ts_barrier" ::: "memory")
#define SC_LOAD(c) do { const int m_ = b * SEQ + (c) * SC_T + tt; const bf16* rowp_ = RKV + (size_t)m_ * NRKV + hc; \
        rc = *(const v2u*)(rowp_ + C_R); kc = *(const v2u*)(rowp_ + C_K); vc = *(const v2u*)(rowp_ + C_V); \
        if ((m_ & (SEQ - 1)) != 0) { rp = *(const v2u*)(rowp_ + C_R - NRKV); kpv = *(const v2u*)(rowp_ + C_K - NRKV); vp = *(const v2u*)(rowp_ + C_V - NRKV); } \
        else { rp = (v2u){0u, 0u}; kpv = rp; vp = rp; } \
        av = *(const v2u*)(AA + (size_t)m_ * RWD + hc); cum4 = *(const f32x4*)(DEC + (size_t)m_ * RWD + hc); \
        if ((tt & 15) != 0) cprev4 = *(const f32x4*)(DEC + (size_t)(m_ - 1) * RWD + hc); else cprev4 = (f32x4){0.f, 0.f, 0.f, 0.f}; } while (0)
#define SC_MIX(cw, pw, muv) ((f32x4){ bflo(cw.x) + (bflo(pw.x) - bflo(cw.x)) * muv.x, bfhi(cw.x) + (bfhi(pw.x) - bfhi(cw.x)) * muv.y, bflo(cw.y) + (bflo(pw.y) - bflo(cw.y)) * muv.z, bfhi(cw.y) + (bfhi(pw.y) - bfhi(cw.y)) * muv.w })
#define ST4(off_, row_, pitch_, v_) do { v2u w_; w_.x = pk2((v_).x, (v_).y); w_.y = pk2((v_).z, (v_).w); *(LAS v2u*)(lds + (off_) + ((row_) * (pitch_) + c4) * 2) = w_; } while (0)
#define STT(off_, v_) do { LAS bf16* p_ = (LAS bf16*)(lds + (off_)) + c4 * TP + tt; const unsigned w0_ = pk2((v_).x, (v_).y), w1_ = pk2((v_).z, (v_).w); p_[0] = (bf16)w0_; p_[TP] = (bf16)(w0_ >> 16); p_[2 * TP] = (bf16)w1_; p_[3 * TP] = (bf16)(w1_ >> 16); } while (0)
    constexpr int NCH = SEQ / SC_T;
    f32x4 zv = (f32x4){0.f, 0.f, 0.f, 0.f}; float bon = 0.f;
    v2u gwn = (v2u){0u, 0u};
    f32x4 zv1 = zv, zv2 = zv; float bon1 = 0.f, bon2 = 0.f;
    SC_LOAD(0);
    for (int c = 0; c <= NCH + 1; ++c) {
        int l15 = l15_, q4 = q4_, tsel = tid; asm volatile("" : "+v"(l15), "+v"(q4), "+v"(tsel));
        const int par = c & 1;
        const int oKT_c = par * (L_KHT2 - L_KHT), oGC_c = par * (L_GC2 - L_GC), oZT_c = par * (L_ZTT2 - L_ZTT), oZK_c = par * (L_ZK2 - L_ZK), oY_c = par * (L_Y1T2 - L_Y1T);
        const int oKT_p = (L_KHT2 - L_KHT) - oKT_c, oGC_p = (L_GC2 - L_GC) - oGC_c, oZT_p = (L_ZTT2 - L_ZTT) - oZT_c, oZK_p = (L_ZK2 - L_ZK) - oZK_c, oY_p = (L_Y1T2 - L_Y1T) - oY_c;
        zv2 = zv1; bon2 = bon1; zv1 = zv; bon1 = bon;
        f32x4 g4 = (f32x4){bflo(gwn.x), bfhi(gwn.x), bflo(gwn.y), bfhi(gwn.y)};
        asm volatile("" : "+v"(g4));
        if (c < NCH) {
        const f32x4 zr = SC_MIX(rc, rp, mu_r), zk = SC_MIX(kc, kpv, mu_k); zv = SC_MIX(vc, vp, mu_v);
        const f32x4 a_ = (f32x4){bflo(av.x), bfhi(av.x), bflo(av.y), bfhi(av.y)};
        f32x4 kap = zk * kk_k; const float ss = red16((kap.x * kap.x + kap.y * kap.y) + (kap.z * kap.z + kap.w * kap.w));
        kap = kap * __builtin_amdgcn_rsqf(fmaxf(ss, 1e-24f));
        const f32x4 k2 = zk * (1.f + (a_ - 1.f) * kk_a); const f32x4 bb = kap * a_;
        const f32x4 t_ = zr * k2 * rr_k; bon = red16((t_.x + t_.y) + (t_.z + t_.w));
        const f32x4 cum = cum4, cumprev = cprev4;
        f32x4 ep, ec, en;
#pragma unroll
        for (int j = 0; j < 4; ++j) { ep[j] = __expf(cumprev[j]); ec[j] = __expf(cum[j]); en[j] = __expf(-cum[j]); }
        const f32x4 kt = kap * ep, rt = zr * ec, kh = k2 * en, nbh = bb * (-en);
        ST4(L_KT, tt, 72, kt); ST4(L_RT, tt, 72, rt); ST4(L_KH, tt, 72, kh); ST4(L_NBH, tt, 72, nbh);
        STT(L_KHT + oKT_c, kh); STT(L_NBHT + oKT_c, nbh); STT(L_VV + oKT_c, zv);
        *(LAS f32x4*)(lds + L_XT + (tt * 132 + 64 + c4) * 4) = kt;
        if ((tt & 15) == 15) *(LAS f32x4*)(lds + L_GC + oGC_c + ((tt >> 4) * 64 + c4) * 4) = ec;
        if (c + 1 < NCH) SC_LOAD(c + 1);
        }
        SC_BAR();
        if (c < NCH) {
        { const int c2 = wave >> 2, vb = wave & 3;
          bf16x8 fkh[2], fkt[2], fnb[2];
#pragma unroll
          for (int ks = 0; ks < 2; ++ks) { const int o = ((16 * c2 + l15) * 72 + 32 * ks + 8 * q4) * 2; fkh[ks] = *(const LAS bf16x8*)(lds + L_KH + o); fkt[ks] = *(const LAS bf16x8*)(lds + L_KT + o); fnb[ks] = *(const LAS bf16x8*)(lds + L_NBH + o); }
          const bf16x4s fvv = *(const LAS bf16x4s*)(lds + L_VV + oKT_c + ((16 * vb + l15) * TP + 16 * c2 + 4 * q4) * 2);
          f32x4 m1 = (f32x4){0.f, 0.f, 0.f, 0.f}, nn = (f32x4){0.f, 0.f, 0.f, 0.f};
          m1 = mfma32(fkh[0], fkt[0], m1); m1 = mfma32(fkh[1], fkt[1], m1);
          if (vb == 0) { nn = mfma32(fnb[0], fkt[0], nn); nn = mfma32(fnb[1], fkt[1], nn); }
#pragma unroll
          for (int r = 0; r < 4; ++r) { if (!(4 * q4 + r < l15)) { m1[r] = 0.f; nn[r] = 0.f; } }
          v2u mw; mw.x = pk2(m1[0], m1[1]); mw.y = pk2(m1[2], m1[3]);
          const f32x4 x1 = mfma16(__builtin_bit_cast(bf16x4s, mw), fvv, (f32x4){0.f, 0.f, 0.f, 0.f});
          if (vb == 0) {
#pragma unroll
              for (int r = 0; r < 4; ++r) *(LAS float*)(lds + L_NT + ((c2 * 16 + 4 * q4 + r) * 16 + l15) * 4) = nn[r]; }
#pragma unroll
          for (int r = 0; r < 4; ++r) *(LAS float*)(lds + L_XT + ((16 * c2 + 4 * q4 + r) * 132 + 16 * vb + l15) * 4) = x1[r]; }
        }
        if (c >= 2) { const int cc_ = c - 2;
        { const int m = b * SEQ + cc_ * SC_T + tt;
          const f32x4 y4 = *(const LAS f32x4*)(lds + L_Y1T + oY_c + (tt * 68 + c4) * 4);
          const float mean = red16((y4.x + y4.y) + (y4.z + y4.w)) * (1.f / 64.f);
          const f32x4 d = y4 - mean; const float var = red16((d.x * d.x + d.y * d.y) + (d.z * d.z + d.w * d.w)) * (1.f / 64.f);
          const float rs = __builtin_amdgcn_rsqf(var + GN_EPS);
          const f32x4 o = (d * rs * gnw + gnb + zv2 * bon2) * g4;
          v2u ow; ow.x = pk2(o.x, o.y); ow.y = pk2(o.z, o.w);
          *(v2u*)(YRW + (size_t)m * D + hc) = ow; }
        }
        if (c >= 1 && c <= NCH) gwn = *(const v2u*)(GG + (size_t)(b * SEQ + (c - 1) * SC_T + tt) * RWD + hc);
        SC_BAR();
        if (tid < 256) { if (c < NCH) { const int c2 = tsel >> 7, col = tsel & 127; float z[16];
#pragma unroll
            for (int t = 0; t < 16; ++t) z[t] = *(const LAS float*)(lds + L_XT + ((16 * c2 + t) * 132 + col) * 4);
#pragma unroll
            for (int i = 0; i < 15; ++i) {
#pragma unroll
                for (int t4 = (i + 1) / 4; t4 < 4; ++t4) { const f32x4 nv = *(const LAS f32x4*)(lds + L_NT + ((c2 * 16 + i) * 16 + 4 * t4) * 4);
#pragma unroll
                    for (int j = 0; j < 4; ++j) if (4 * t4 + j > i) z[4 * t4 + j] += nv[j] * z[i]; } }
            v4u w0, w1; w0.x = pk2(z[0], z[1]); w0.y = pk2(z[2], z[3]); w0.z = pk2(z[4], z[5]); w0.w = pk2(z[6], z[7]); w1.x = pk2(z[8], z[9]); w1.y = pk2(z[10], z[11]); w1.z = pk2(z[12], z[13]); w1.w = pk2(z[14], z[15]);
            LAS v2u* zp = (LAS v2u*)(lds + L_ZTT + oZT_c + (col * TP + 16 * c2) * 2); zp[0] = (v2u){w0.x, w0.y}; zp[1] = (v2u){w0.z, w0.w}; zp[2] = (v2u){w1.x, w1.y}; zp[3] = (v2u){w1.z, w1.w};
            if (col >= 64) { LAS bf16* zk = (LAS bf16*)(lds + L_ZK + oZK_c) + (16 * c2) * 72 + (col - 64); const unsigned ww[8] = {w0.x, w0.y, w0.z, w0.w, w1.x, w1.y, w1.z, w1.w};
#pragma unroll
                for (int j = 0; j < 8; ++j) { zk[(2 * j) * 72] = (bf16)ww[j]; zk[(2 * j + 1) * 72] = (bf16)(ww[j] >> 16); } } } }
        else if (c > 0 && c <= NCH) {
            { const int vb = wave & 3;
#pragma unroll
              for (int c2 = 0; c2 < 2; ++c2) {
                  bf16x8 fq[2], fz[2], fs[2];
#pragma unroll
                  for (int ks = 0; ks < 2; ++ks) { const int o = ((16 * c2 + l15) * 72 + 32 * ks + 8 * q4) * 2; fq[ks] = *(const LAS bf16x8*)(lds + L_QT + o); fz[ks] = *(const LAS bf16x8*)(lds + L_ZK + oZK_p + o);
                      fs[ks] = *(const LAS bf16x8*)(lds + L_S0 + ((16 * vb + l15) * 72 + 32 * ks + 8 * q4) * 2); }
                  f32x4 yacc;
#pragma unroll
                  for (int r = 0; r < 4; ++r) yacc[r] = *(const LAS float*)(lds + L_Y1T + oY_p + ((16 * c2 + 4 * q4 + r) * 68 + 16 * vb + l15) * 4);
                  const v2u zvw = *(const LAS v2u*)(lds + L_ZTT + oZT_p + ((16 * vb + l15) * TP + 16 * c2 + 4 * q4) * 2);
                  const bf16x4s fv = *(const LAS bf16x4s*)(lds + L_VV + oKT_p + ((16 * vb + l15) * TP + 16 * c2 + 4 * q4) * 2);
                  bf16x4s fn[4], fk[4]; float gc[4];
#pragma unroll
                  for (int kb = 0; kb < 4; ++kb) { fn[kb] = *(const LAS bf16x4s*)(lds + L_NBHT + oKT_p + ((16 * kb + l15) * TP + 16 * c2 + 4 * q4) * 2); fk[kb] = *(const LAS bf16x4s*)(lds + L_KHT + oKT_p + ((16 * kb + l15) * TP + 16 * c2 + 4 * q4) * 2);
                      gc[kb] = *(const LAS float*)(lds + L_GC + oGC_p + (c2 * 64 + 16 * kb + l15) * 4); }
                  yacc = mfma32(fq[0], fs[0], yacc); yacc = mfma32(fq[1], fs[1], yacc);
                  f32x4 acc = (f32x4){bflo(zvw.x), bfhi(zvw.x), bflo(zvw.y), bfhi(zvw.y)};
                  acc = mfma32(fz[0], fs[0], acc); acc = mfma32(fz[1], fs[1], acc);
#pragma unroll
                  for (int r = 0; r < 4; ++r) *(LAS float*)(lds + L_Y1T + oY_p + ((16 * c2 + 4 * q4 + r) * 68 + 16 * vb + l15) * 4) = yacc[r];
                  v2u uw; uw.x = pk2(acc[0], acc[1]); uw.y = pk2(acc[2], acc[3]); const bf16x4s fu = __builtin_bit_cast(bf16x4s, uw);
#pragma unroll
                  for (int kb = 0; kb < 4; ++kb) { Sacc[kb] = mfma16(fu, fn[kb], Sacc[kb]); Sacc[kb] = mfma16(fv, fk[kb], Sacc[kb]); }
#pragma unroll
                  for (int kb = 0; kb < 4; ++kb) { Sacc[kb] = Sacc[kb] * gc[kb]; const unsigned w0_ = pk2(Sacc[kb][0], Sacc[kb][1]), w1_ = pk2(Sacc[kb][2], Sacc[kb][3]);
                      LAS bf16* sp = (LAS bf16*)(lds + L_S0) + (16 * vb + 4 * q4) * 72 + 16 * kb + l15;
                      sp[0] = (bf16)w0_; sp[72] = (bf16)(w0_ >> 16); sp[144] = (bf16)w1_; sp[216] = (bf16)(w1_ >> 16); }
                  LDS_WAIT();
              } }
        }
        SC_BAR();
        if (c < NCH) {
        { const int c2 = wave >> 2;
          bf16x8 fkh[2], frt[2], fnb[2];
#pragma unroll
          for (int ks = 0; ks < 2; ++ks) { const int o = ((16 * c2 + l15) * 72 + 32 * ks + 8 * q4) * 2; fkh[ks] = *(const LAS bf16x8*)(lds + L_KH + o); frt[ks] = *(const LAS bf16x8*)(lds + L_RT + o); fnb[ks] = *(const LAS bf16x8*)(lds + L_NBH + o); }
          bf16x4s fb[2], fb2[2]; float rtv[2][4];
#pragma unroll
          for (int j = 0; j < 2; ++j) { const int nb = (2 * wave + j) & 7;
              fb[j] = *(const LAS bf16x4s*)(lds + L_ZTT + oZT_c + ((16 * nb + l15) * TP + 16 * c2 + 4 * q4) * 2); fb2[j] = *(const LAS bf16x4s*)(lds + L_VV + oKT_c + ((16 * (nb & 3) + l15) * TP + 16 * c2 + 4 * q4) * 2);
#pragma unroll
              for (int r = 0; r < 4; ++r) rtv[j][r] = bflo((unsigned)*(const LAS bf16*)(lds + L_RT + ((16 * c2 + 4 * q4 + r) * 72 + 16 * (nb & 3) + l15) * 2)); }
          f32x4 m2 = (f32x4){0.f, 0.f, 0.f, 0.f}, n2 = (f32x4){0.f, 0.f, 0.f, 0.f};
          n2 = mfma32(fnb[0], frt[0], n2); n2 = mfma32(fnb[1], frt[1], n2);
          const bool needm2 = ((2 * wave) & 7) < 4;
          if (needm2) { m2 = mfma32(fkh[0], frt[0], m2); m2 = mfma32(fkh[1], frt[1], m2); }
#pragma unroll
          for (int r = 0; r < 4; ++r) { if (!(4 * q4 + r <= l15)) { m2[r] = 0.f; n2[r] = 0.f; } }
          v2u w2; w2.x = pk2(n2[0], n2[1]); w2.y = pk2(n2[2], n2[3]); const bf16x4s fn2 = __builtin_bit_cast(bf16x4s, w2);
          v2u w3; w3.x = pk2(m2[0], m2[1]); w3.y = pk2(m2[2], m2[3]); const bf16x4s fm2 = __builtin_bit_cast(bf16x4s, w3);
          f32x4 acc[2];
#pragma unroll
          for (int j = 0; j < 2; ++j) { acc[j] = mfma16(fn2, fb[j], (f32x4){0.f, 0.f, 0.f, 0.f}); if (needm2) acc[j] = mfma16(fm2, fb2[j], acc[j]); }
#pragma unroll
          for (int j = 0; j < 2; ++j) { const int nb = (2 * wave + j) & 7;
              if (nb < 4) {
#pragma unroll
                  for (int r = 0; r < 4; ++r) *(LAS float*)(lds + L_Y1T + oY_c + ((16 * c2 + 4 * q4 + r) * 68 + 16 * nb + l15) * 4) = acc[j][r]; }
              else { const unsigned w0_ = pk2(acc[j][0] + rtv[j][0], acc[j][1] + rtv[j][1]), w1_ = pk2(acc[j][2] + rtv[j][2], acc[j][3] + rtv[j][3]);
                  LAS bf16* qp = (LAS bf16*)(lds + L_QT) + (16 * c2 + 4 * q4) * 72 + 16 * (nb - 4) + l15;
                  qp[0] = (bf16)w0_; qp[72] = (bf16)(w0_ >> 16); qp[144] = (bf16)w1_; qp[216] = (bf16)(w1_ >> 16); } } }
        }
        SC_BAR();
    }
    __syncthreads();
#undef SC_BAR
#undef SC_LOAD
#undef SC_MIX
#undef ST4
#undef STT
}

constexpr int AT_SLOT = 12288, AT_K = 0, AT_V = 3 * AT_SLOT, AT_WS = 6 * AT_SLOT, AT_OST = AT_WS + 8 * 256, AT_END = AT_OST + 8 * 4096;
static_assert(AT_END <= 131072, "attention LDS");
constexpr int ATP = 1024;
constexpr int AT_THR = 8;
typedef LAS const char* at_lptr; typedef short at_v4i16 __attribute__((ext_vector_type(4)));
__device__ __forceinline__ int at_crow(int r, int hi) { return (r & 3) + 8 * (r >> 2) + 4 * hi; }
__device__ __forceinline__ void at_glds16(const void* sbase, unsigned voff, unsigned lds_dst) { unsigned keep;
    asm volatile("s_mov_b32 %0, m0\n\ts_mov_b32 m0, %3\n\ts_nop 0\n\tglobal_load_lds_dwordx4 %1, %2\n\ts_mov_b32 m0, %0" : "=&s"(keep) : "v"(voff), "s"(sbase), "s"(lds_dst) : "memory"); }
__device__ __forceinline__ void at_kload2(bf16x8* kf, at_lptr kp, int j) { kf[2 * j] = *(const LAS bf16x8*)(kp + j * 2048); kf[2 * j + 1] = *(const LAS bf16x8*)(kp + j * 2048 + 512); }
__device__ __forceinline__ bf16x4 at_vtr(at_lptr p) { return __builtin_bit_cast(bf16x4, __builtin_amdgcn_ds_read_tr16_b64_v4i16((LAS at_v4i16*)p)); }
__device__ __forceinline__ void at_cmask(f32x16& p0, f32x16& p1, int jb, int qrel, int hi) {
    const int kb = 64 * jb + 4 * hi;
#pragma unroll
    for (int r = 0; r < 16; ++r) { const int kv = kb + (r & 3) + 8 * (r >> 2); if (kv > qrel) p0[r] = -INFINITY; if (kv + 32 > qrel) p1[r] = -INFINITY; }
}
#define AT_MFMA(a, b, c) __builtin_amdgcn_mfma_f32_32x32x16_bf16(a, b, c, 0, 0, 0)
#define AT_SBAR() __builtin_amdgcn_sched_barrier(0)
#define AT_PIN(x) asm volatile("" : "+v"(x))
#define AT_WAIT_BAR(N) asm volatile("s_waitcnt vmcnt(" #N ") lgkmcnt(0)\n\ts_barrier" ::: "memory")
#define AT_MX3(a, b, c) __builtin_fmaxf(__builtin_fmaxf((a), (b)), (c))
__device__ __forceinline__ float at_rowmax(const f32x16& p0, const f32x16& p1) {
    float a = AT_MX3(p0[0], p0[1], p1[0]), b = AT_MX3(p0[2], p0[3], p1[1]); a = AT_MX3(a, p1[2], p1[3]);
#pragma unroll
    for (int r = 4; r < 16; r += 4) { a = AT_MX3(a, p0[r], p0[r + 1]); b = AT_MX3(b, p0[r + 2], p0[r + 3]); a = AT_MX3(a, p1[r], p1[r + 1]); b = AT_MX3(b, p1[r + 2], p1[r + 3]); }
    float m = __builtin_fmaxf(a, b); auto rr = __builtin_amdgcn_permlane32_swap(__float_as_uint(m), __float_as_uint(m), false, false);
    return __builtin_fmaxf(__uint_as_float(rr[0]), __uint_as_float(rr[1]));
}
__device__ __forceinline__ void attn_unit(const Frame& F, int b, int h, int qb) {
    unsigned char* ws = F.ws;
    const int lane = F.lane, r32 = lane & 31, hi = lane >> 5, wid = F.wave;
    const size_t rowbase = (size_t)b * SEQ; const int q0 = qb * 256;
    const bf16* Qw = (const bf16*)(ws + WS_Q) + (rowbase + q0 + wid * 32) * QPITCH + h * QKD;
    const char* Kh = (const char*)((const bf16*)(ws + WS_K) + rowbase * ATP + h * HD);
    const char* Krp = (const char*)((const bf16*)(ws + WS_KROPE) + rowbase * 32);
    LAS unsigned char* shm = F.lds;
    const unsigned lds0 = (unsigned)(size_t)shm;
    LAS float* wsf = (LAS float*)(shm + AT_WS) + wid * 64;
    const unsigned koff = (unsigned)(lane * ATP) * 2u;
    const unsigned voff = (unsigned)(512 + (16 * (wid & 3) + (lane >> 2)) * ATP + (wid >> 2) * 32 + (lane & 3) * 8) * 2u;
    const unsigned kdst = lds0 + AT_K + wid * 1024, kdst2 = lds0 + AT_K + (8 + (wid & 3)) * 1024, vdst = lds0 + AT_V + wid * 1024;
#define DMA_K(t, slot) do { at_glds16(Kh + wid * 16 + (size_t)(t) * (64 * ATP * 2), koff, (unsigned)__builtin_amdgcn_readfirstlane(kdst + (slot))); unsigned k2_; asm volatile("v_lshrrev_b32 %0, 5, %1" : "=v"(k2_) : "v"(koff)); at_glds16(Krp + (wid & 3) * 16 + (size_t)(t) * (64 * 32 * 2), k2_, (unsigned)__builtin_amdgcn_readfirstlane(kdst2 + (slot))); } while (0)
#define DMA_V(t, slot) at_glds16(Kh + (size_t)(t) * (64 * ATP * 2), voff, (unsigned)__builtin_amdgcn_readfirstlane(vdst + (slot)))
    const at_lptr shm3 = (at_lptr)shm; const at_lptr kp0 = shm3 + AT_K + hi * 1024 + r32 * 16;
    const at_lptr vp0 = shm3 + AT_V + ((lane >> 4) & 1) * 32 + (lane & 3) * 8 + (4 * hi + ((lane & 15) >> 2)) * 64;
    const int NT = (q0 + 256) / 64;
    DMA_K(0, 0); DMA_V(0, 0); DMA_K(1, AT_SLOT);
    bf16x8 qr[6];
#pragma unroll
    for (int d0 = 0; d0 < 6; ++d0) qr[d0] = *(const bf16x8*)(Qw + (size_t)r32 * QPITCH + d0 * 16 + hi * 8);
    float mhat = 0.f, l_reg = 0.f; f32x16 o[2], negm;
    { float z = 0.f; asm volatile("" : "+v"(z));
#pragma unroll
      for (int r = 0; r < 16; ++r) { o[0][r] = z; o[1][r] = z; negm[r] = z; } }
    AT_PIN(negm);
    const int qrel = wid * 32 + r32; bool resc = false;
    f32x16 pA0, pA1, pB0, pB1; bf16x8 kf[12]; bf16x4 vlo[8], vhi[8]; v4u pw0, pw1, pw2, pw3;
    int sl_prev = 0, sl_cur = 0, sl_next = AT_SLOT;
#define ROT() do { sl_prev = sl_cur; sl_cur = sl_next; sl_next = (sl_next == 2 * AT_SLOT) ? 0 : sl_next + AT_SLOT; } while (0)
#define RESC() do { if (resc) { LDS_WAIT(); _Pragma("unroll") for (int d_ = 0; d_ < 2; ++d_) _Pragma("unroll") for (int r = 0; r < 16; ++r) o[d_][r] *= wsf[at_crow(r, hi)]; } } while (0)
#define CMASKB(P0, P1, t) do { const int jb_ = (t) - (NT - 4); if (jb_ >= 0) at_cmask(P0, P1, jb_, qrel, hi); } while (0)
    DMA_K(2, 2 * AT_SLOT);
    AT_WAIT_BAR(5);
#pragma unroll
    for (int d0 = 0; d0 < 6; ++d0) at_kload2(kf, kp0, d0);
    pA0 = AT_MFMA(kf[0], qr[0], negm); pA1 = AT_MFMA(kf[1], qr[0], negm);
#pragma unroll
    for (int d0 = 1; d0 < 6; ++d0) { pA0 = AT_MFMA(kf[2 * d0], qr[d0], pA0); pA1 = AT_MFMA(kf[2 * d0 + 1], qr[d0], pA1); }
    CMASKB(pA0, pA1, 0);
    { const float rm = at_rowmax(pA0, pA1); mhat = rm;
#pragma unroll
      for (int r = 0; r < 16; ++r) { pA0[r] = __builtin_amdgcn_exp2f(pA0[r] - rm); pA1[r] = __builtin_amdgcn_exp2f(pA1[r] - rm); negm[r] = -rm; }
      AT_PIN(negm); }
    AT_WAIT_BAR(0);
    DMA_K(3, 0); DMA_V(1, AT_SLOT); ROT();
#pragma unroll
    for (int d0 = 0; d0 < 6; ++d0) at_kload2(kf, kp0 + sl_cur, d0);
    AT_WAIT_BAR(3);
#define PKW(P, i) pk2(P[i], P[(i) + 1])
#define PAF(k) __builtin_bit_cast(bf16x8, pw##k)
#define VFR(i) (bf16x8){vlo[i][0], vlo[i][1], vlo[i][2], vlo[i][3], vhi[i][0], vhi[i][1], vhi[i][2], vhi[i][3]}
#define VRD(i) do { vlo[i] = at_vtr(vp_ + (((i) >> 2) * 4096 + ((i) & 3) * 1024)); vhi[i] = at_vtr(vp_ + (((i) >> 2) * 4096 + ((i) & 3) * 1024 + 512)); } while (0)
#define KRD(G, j) do { if (G) { at_kload2(kf, kp0 + sl_next, j); AT_SBAR(); } } while (0)
#define GAPA(MF, a0, a1, a2, a3, W0, W1, PW) do { MF; sacc += a0; sacc += a1; sacc += a2; sacc += a3; AT_PIN(sacc); W0; W1; AT_PIN(PW); AT_SBAR(); } while (0)
#define EX(v) __builtin_amdgcn_exp2f(v)
#define GAPB(MF, X, i) do { MF; X[i] = EX(X[i]); X[(i) + 1] = EX(X[(i) + 1]); X[(i) + 2] = EX(X[(i) + 2]); X[(i) + 3] = EX(X[(i) + 3]); AT_PIN(X); AT_SBAR(); } while (0)
#define STEP(C0, C1, P0, P1, t, MASK, GK, GV, GL) do { AT_SBAR(); \
    const at_lptr vp_ = vp0 + sl_prev; \
    VRD(0); AT_SBAR(); float sacc = P0[0] + P0[1]; \
                       GAPA(C0 = AT_MFMA(kf[0], qr[0], negm), P0[2], P0[3], P0[4], P0[5],     pw0[0] = PKW(P0, 0),  pw0[1] = PKW(P0, 2),  pw0); \
    VRD(4); AT_SBAR(); GAPA(C1 = AT_MFMA(kf[1], qr[0], negm), P0[6], P0[7], P0[8], P0[9],     pw0[2] = PKW(P0, 4),  pw0[3] = PKW(P0, 6),  pw0); \
    VRD(1); AT_SBAR(); GAPA(C0 = AT_MFMA(kf[2], qr[1], C0),   P0[10], P0[11], P0[12], P0[13], pw1[0] = PKW(P0, 8),  pw1[1] = PKW(P0, 10), pw1); \
    VRD(5); AT_SBAR(); GAPA(C1 = AT_MFMA(kf[3], qr[1], C1),   P0[14], P0[15], P1[0], P1[1],   pw1[2] = PKW(P0, 12), pw1[3] = PKW(P0, 14), pw1); \
    VRD(2); AT_SBAR(); GAPA(C0 = AT_MFMA(kf[4], qr[2], C0),   P1[2], P1[3], P1[4], P1[5],     pw2[0] = PKW(P1, 0),  pw2[1] = PKW(P1, 2),  pw2); \
    VRD(6); AT_SBAR(); GAPA(C1 = AT_MFMA(kf[5], qr[2], C1),   P1[6], P1[7], P1[8], P1[9],     pw2[2] = PKW(P1, 4),  pw2[3] = PKW(P1, 6),  pw2); \
    VRD(3); AT_SBAR(); GAPA(C0 = AT_MFMA(kf[6], qr[3], C0),   P1[10], P1[11], P1[12], P1[13], pw3[0] = PKW(P1, 8),  pw3[1] = PKW(P1, 10), pw3); \
    VRD(7); AT_SBAR(); GAPA(C1 = AT_MFMA(kf[7], qr[3], C1),   P1[14], P1[15], 0.f, 0.f,       pw3[2] = PKW(P1, 12), pw3[3] = PKW(P1, 14), pw3); \
    C0 = AT_MFMA(kf[8], qr[4], C0); C1 = AT_MFMA(kf[9], qr[4], C1); C0 = AT_MFMA(kf[10], qr[5], C0); C1 = AT_MFMA(kf[11], qr[5], C1); AT_SBAR();     \
    l_reg += sacc; \
    if (GK) DMA_K((t) + 3, sl_cur); if (GV) DMA_V((t) + 1, sl_next);                                         \
    if (MASK) CMASKB(C0, C1, t); \
    { const float rm = at_rowmax(C0, C1); resc = false;                                                       \
      if (__builtin_expect(__any(rm > (float)AT_THR), 0)) { const float dl = __builtin_fmaxf(rm, 0.f); mhat += dl;     \
          _Pragma("unroll") for (int r = 0; r < 16; ++r) { C0[r] -= dl; C1[r] -= dl; } \
          _Pragma("unroll") for (int r = 0; r < 16; ++r) negm[r] = -mhat; AT_PIN(negm); \
          const float f = __builtin_amdgcn_exp2f(-dl); l_reg *= f; if (hi == 0) wsf[r32] = f; resc = true; } } \
    AT_SBAR(); \
    GAPB(o[0] = AT_MFMA(PAF(0), VFR(0), o[0]), C0, 0);               GAPB(o[1] = AT_MFMA(PAF(0), VFR(4), o[1]), C0, 4); \
    KRD(GL, 0); GAPB(o[0] = AT_MFMA(PAF(1), VFR(1), o[0]), C0, 8);   KRD(GL, 1); GAPB(o[1] = AT_MFMA(PAF(1), VFR(5), o[1]), C0, 12); \
    KRD(GL, 2); GAPB(o[0] = AT_MFMA(PAF(2), VFR(2), o[0]), C1, 0);   KRD(GL, 3); GAPB(o[1] = AT_MFMA(PAF(2), VFR(6), o[1]), C1, 4); \
    KRD(GL, 4); GAPB(o[0] = AT_MFMA(PAF(3), VFR(3), o[0]), C1, 8);   KRD(GL, 5); GAPB(o[1] = AT_MFMA(PAF(3), VFR(7), o[1]), C1, 12); \
    } while (0)
    int t = 1;
    for (; t + 5 < NT; t += 2) {
        STEP(pB0, pB1, pA0, pA1, t, false, true, true, true);     AT_WAIT_BAR(3); RESC(); ROT();
        STEP(pA0, pA1, pB0, pB1, t + 1, false, true, true, true); AT_WAIT_BAR(3); RESC(); ROT();
    }
#define ENDW(tt) do { if ((tt) + 3 < NT) { AT_WAIT_BAR(3); } else if ((tt) + 2 < NT) { AT_WAIT_BAR(1); } else { AT_WAIT_BAR(0); } } while (0)
    for (; t + 1 < NT; t += 2) {
        STEP(pB0, pB1, pA0, pA1, t, true, (t + 3 < NT), (t + 1 < NT), (t + 1 < NT));         ENDW(t);     RESC(); ROT();
        STEP(pA0, pA1, pB0, pB1, t + 1, true, (t + 4 < NT), (t + 2 < NT), (t + 2 < NT));     ENDW(t + 1); RESC(); ROT();
    }
    STEP(pB0, pB1, pA0, pA1, NT - 1, true, false, false, false); RESC();
    { float sacc = pB0[0] + pB0[1];
#pragma unroll
      for (int r = 2; r < 16; ++r) sacc += pB0[r];
#pragma unroll
      for (int r = 0; r < 16; ++r) sacc += pB1[r];
      l_reg += sacc;
      pw0 = (v4u){PKW(pB0, 0), PKW(pB0, 2), PKW(pB0, 4), PKW(pB0, 6)}; pw1 = (v4u){PKW(pB0, 8), PKW(pB0, 10), PKW(pB0, 12), PKW(pB0, 14)};
      pw2 = (v4u){PKW(pB1, 0), PKW(pB1, 2), PKW(pB1, 4), PKW(pB1, 6)}; pw3 = (v4u){PKW(pB1, 8), PKW(pB1, 10), PKW(pB1, 12), PKW(pB1, 14)};
      const at_lptr vp_ = vp0 + sl_cur;
#pragma unroll
      for (int i = 0; i < 8; ++i) VRD(i);
      o[0] = AT_MFMA(PAF(0), VFR(0), o[0]); o[1] = AT_MFMA(PAF(0), VFR(4), o[1]); o[0] = AT_MFMA(PAF(1), VFR(1), o[0]); o[1] = AT_MFMA(PAF(1), VFR(5), o[1]);
      o[0] = AT_MFMA(PAF(2), VFR(2), o[0]); o[1] = AT_MFMA(PAF(2), VFR(6), o[1]); o[0] = AT_MFMA(PAF(3), VFR(3), o[0]); o[1] = AT_MFMA(PAF(3), VFR(7), o[1]); }
    { auto rr = __builtin_amdgcn_permlane32_swap(__float_as_uint(l_reg), __float_as_uint(l_reg), false, false); l_reg = __uint_as_float(rr[0]) + __uint_as_float(rr[1]); }
    if (hi == 0) wsf[32 + r32] = l_reg;
    LDS_WAIT();
    float rli[16];
#pragma unroll
    for (int r = 0; r < 16; ++r) rli[r] = __builtin_amdgcn_rcpf(wsf[32 + at_crow(r, hi)]);
    LAS bf16* stg = (LAS bf16*)(shm + AT_OST) + wid * 2048;
    bf16* Ow = (bf16*)(ws + WS_YCAT) + (rowbase + q0 + wid * 32) * D + RWD + h * HD;
#pragma unroll
    for (int r = 0; r < 16; ++r) { const int orow = at_crow(r, hi); const unsigned w = pk2(o[0][r] * rli[r], o[1][r] * rli[r]);
        stg[orow * 64 + r32] = (bf16)(w & 0xffffu); stg[orow * 64 + 32 + r32] = (bf16)(w >> 16); }
    LDS_WAIT();
#pragma unroll
    for (int i = 0; i < 4; ++i) { const int row = i * 8 + (lane >> 3), ch = lane & 7; *(v4u*)(Ow + (size_t)row * D + ch * 8) = *(const LAS v4u*)(stg + row * 64 + ch * 8); }
    asm volatile("s_waitcnt lgkmcnt(0)\n\ts_barrier" ::: "memory");
#undef DMA_K
#undef DMA_V
#undef ROT
#undef RESC
#undef CMASKB
#undef PKW
#undef PAF
#undef VFR
#undef VRD
#undef KRD
#undef GAPA
#undef EX
#undef GAPB
#undef STEP
#undef ENDW
}
__device__ __forceinline__ void attn_phase(const Frame& F, int bh) {
    for (int qb = SEQ / 256 - 1; qb >= 0; --qb) attn_unit(F, bh >> 3, bh & 7, qb);
    VM_WAIT(); __syncthreads();
}

constexpr int MOEW_ITEMS = 32 * 16 * 16 + 32 * 4 * 32, MOEW_SPLIT = MOEW_ITEMS * 5 / 8;
__device__ __forceinline__ void p5_moe_weights(const Frame& F, const float* w_gu, const float* w_down, const float* ffn_g, int wg, int nwg, int it0, int it1) {
    unsigned char* ws = F.ws; LAS float* scr = (LAS float*)(F.lds + F.wave * 16384);
    const int gw = wg * NWAVES + F.wave, NGW = nwg * NWAVES, lane = F.lane;
    constexpr int I_GU = 32 * 16 * 16, I_DN = 32 * 4 * 32;
    for (int it = it0 + gw; it < it1; it += NGW) {
        int r = it;
        if (r < I_GU) { const int e = r / 256, q = r % 256, kb = q / 16, nb = q % 16, n0 = nb * 32; const int cc = n0 & 255; const int dst = 256 * (cc >> 7) + (n0 >= 256 ? 128 : 0) + (cc & 127);
            p0_transpose_item<true>(w_gu + (size_t)e * D * 512, 512, kb * 64, n0, (bf16*)(ws + WS_WGU + (size_t)e * 512 * D), D, dst, ffn_g, scr, lane); continue; } r -= I_GU;
        { const int e = r / 128, q = r % 128, kb = q / 32, nb = q % 32;
            p0_transpose_item<true>(w_down + (size_t)e * DEXP * D, D, kb * 64, nb * 32, (bf16*)(ws + WS_WD + (size_t)e * D * DEXP), DEXP, nb * 32, nullptr, scr, lane); }
    }
}
__device__ __forceinline__ void p9_route(const Frame& F, const float* b_group, const float* b_router, int row0, int nrows) {
    unsigned char* ws = F.ws; const int tid = F.tid;
    const float* LG = (const float*)(ws + WS_LOGITS);
    int* ROUTE = (int*)(ws + WS_ROUTE); int* TB = (int*)(ws + WS_TOK2); float* WB = (float*)(ws + WS_WB2); float* RSB = (float*)(ws + WS_RSB2); const float* SS = (const float*)(ws + WS_SQ);
    LAS int* hist = (LAS int*)(F.lds + MISC_OFF + 192); LAS int* base = (LAS int*)(F.lds + MISC_OFF + 320);
    if (tid < 32) hist[tid] = 0;
    __syncthreads();
    int e1 = 0, e2 = 0, l1 = 0, l2 = 0; float w1 = 0.f, w2 = 0.f; const bool act = tid < nrows; const int m = row0 + tid;
    if (act) {
        const float* lg = LG + (size_t)m * 64;
        float g[4]; int gs = 0; float gm;
#pragma unroll
        for (int j = 0; j < 4; ++j) g[j] = lg[j] + b_group[j];
        gm = g[0];
#pragma unroll
        for (int j = 1; j < 4; ++j) if (g[j] > gm) { gm = g[j]; gs = j; }
        float den = 0.f;
#pragma unroll
        for (int j = 0; j < 4; ++j) den += __expf(g[j] - gm);
        const float gate_g = 1.f / den;
        float f[8];
#pragma unroll
        for (int j = 0; j < 8; ++j) f[j] = lg[4 + 8 * gs + j] + b_router[8 * gs + j];
        int i1 = 0; float v1 = f[0];
#pragma unroll
        for (int j = 1; j < 8; ++j) if (f[j] > v1) { v1 = f[j]; i1 = j; }
        int i2 = -1; float v2 = -INFINITY;
#pragma unroll
        for (int j = 0; j < 8; ++j) if (j != i1 && f[j] > v2) { v2 = f[j]; i2 = j; }
        const float ex = __expf(v2 - v1); w1 = gate_g / (1.f + ex); w2 = gate_g * ex / (1.f + ex);
        e1 = 8 * gs + i1; e2 = 8 * gs + i2;
        l1 = atomicAdd((int*)(hist + e1), 1); l2 = atomicAdd((int*)(hist + e2), 1);
    }
    __syncthreads();
    if (tid < 32) base[tid] = (int)__hip_atomic_fetch_add((unsigned*)(F.ctl + CW_CNT + tid), (unsigned)hist[tid], RLX_AGENT);
    __syncthreads();
    if (act) { const int r1 = base[e1] + l1, r2 = base[e2] + l2; *(int4*)(ROUTE + (size_t)m * 4) = make_int4(e1, e2, r1, r2);
        const float rs = 1.f / sqrtf(SS[m] * (1.f / D) + NORM_EPS); const int d1 = e1 * MOE_CAP + r1, d2 = e2 * MOE_CAP + r2;
        TB[d1] = m; TB[d2] = m; WB[d1] = w1; WB[d2] = w2; RSB[d1] = rs; RSB[d2] = rs; }
}
__device__ __forceinline__ void moe_offsets(const Frame& F) {
    LAS int* PE = (LAS int*)(F.lds + MISC_OFF + 64); LAS int* PS = (LAS int*)(F.lds + MISC_OFF + 448); LAS int* BLK = (LAS int*)(F.lds + MISC_OFF + 192);
    if (F.tid < NEXP) { const int c = (int)__hip_atomic_load((unsigned*)(F.ctl + CW_CNT + F.tid), RLX_AGENT); BLK[F.tid] = (c + 255) >> 8; }
    __syncthreads();
    if (F.tid < NEXP) { int accb = 0; for (int e = 0; e < F.tid; ++e) accb += BLK[e]; PS[F.tid] = accb * 256; PE[F.tid] = accb + BLK[F.tid]; }
    __syncthreads();
}
__device__ __forceinline__ void p10_scatter(const Frame& F) {
    unsigned char* ws = F.ws; const int tid = F.tid;
    moe_offsets(F);
    const LAS int* PS = (const LAS int*)(F.lds + MISC_OFF + 448);
    const int* ROUTE = (const int*)(ws + WS_ROUTE); const float* GW = (const float*)(ws + WS_GATEW);
    int* TB = (int*)(ws + WS_TOKBUF); float* WB = (float*)(ws + WS_WBUF); int* POS = (int*)(ws + WS_POS); float* RSB = (float*)(ws + WS_RSB); const float* SS = (const float*)(ws + WS_SQ);
    const int per = M / F.G;
    if (tid < per) { const int m = F.vcu * per + tid; const int4 r = *(const int4*)(ROUTE + (size_t)m * 4); const float2 w = *(const float2*)(GW + (size_t)m * 2);
        const int d1 = PS[r.x] + r.z, d2 = PS[r.y] + r.w;
        const float rs = 1.f / sqrtf(SS[m] * (1.f / D) + NORM_EPS); RSB[d1] = rs; RSB[d2] = rs;
        TB[d1] = m; TB[d2] = m; WB[d1] = w.x; WB[d2] = w.y; *(int2*)(POS + (size_t)m * 2) = make_int2(d1, d2); }
}

__device__ __forceinline__ void p13_final(const Frame& F, const float* fin_g, const XcdBarrier wbar, const bool wb) {
    float* OUT = F.out; const bf16* XB = (const bf16*)(F.ws + WS_XN); const unsigned char* Y = F.ws + WS_Y; const int4* ROUTE = (const int4*)(F.ws + WS_ROUTE); const LAS int* PS = (const LAS int*)(F.lds + MISC_OFF + 448); const int lane = F.lane;
    const int gw = F.vcu * NWAVES + F.wave, NGW = F.G * NWAVES;
    f32x4 gv[4];
#pragma unroll
    for (int j = 0; j < 4; ++j) gv[j] = ((const f32x4*)fin_g + lane)[64 * j];
    asm volatile("" : "+v"(gv[0]), "+v"(gv[1]), "+v"(gv[2]), "+v"(gv[3]));
    int4 rna = make_int4(0, 0, 0, 0), rnb = rna;
    if (gw < M) { rna = ROUTE[gw]; rnb = ROUTE[gw + NGW < M ? gw + NGW : gw]; }
    if (wb) xcd_barrier_wait(wbar);
    for (int m = gw; m < M; m += 2 * NGW) {
        const int m2 = m + NGW;
        const bool has2 = m2 < M; const int mb = has2 ? m2 : m;
        const int4 ra_ = rna, rb_ = rnb;
        { const int mn = m + 2 * NGW; if (mn < M) { rna = ROUTE[mn]; rnb = ROUTE[mn + NGW < M ? mn + NGW : mn]; } } const int2 pa = make_int2(PS[ra_.x] + ra_.z, PS[ra_.y] + ra_.w), pb = make_int2(PS[rb_.x] + rb_.z, PS[rb_.y] + rb_.w);
        const v2u* xa = (const v2u*)(XB + (size_t)m * D) + lane; const unsigned* ya1 = (const unsigned*)(Y + (size_t)pa.x * D) + lane; const unsigned* ya2 = (const unsigned*)(Y + (size_t)pa.y * D) + lane;
        const v2u* xb = (const v2u*)(XB + (size_t)mb * D) + lane; const unsigned* yb1 = (const unsigned*)(Y + (size_t)pb.x * D) + lane; const unsigned* yb2 = (const unsigned*)(Y + (size_t)pb.y * D) + lane;
        v2u ax[4], bx[4]; unsigned a1[4], a2[4], b1[4], b2[4];
#pragma unroll
        for (int j = 0; j < 4; ++j) { ax[j] = xa[64 * j]; a1[j] = ya1[64 * j]; a2[j] = ya2[64 * j]; bx[j] = xb[64 * j]; b1[j] = yb1[64 * j]; b2[j] = yb2[64 * j]; }
        f32x4 va[4], vb[4]; float sa = 0.f, sb = 0.f;
#pragma unroll
        for (int j = 0; j < 4; ++j) {
            constexpr float YI = 1.f / Y_SCALE;
            { const auto p1l = __builtin_amdgcn_cvt_pk_f32_fp8((int)a1[j], false), p1h = __builtin_amdgcn_cvt_pk_f32_fp8((int)a1[j], true), p2l = __builtin_amdgcn_cvt_pk_f32_fp8((int)a2[j], false), p2h = __builtin_amdgcn_cvt_pk_f32_fp8((int)a2[j], true);
              va[j].x = bflo(ax[j].x) + (p1l[0] + p2l[0]) * YI; va[j].y = bfhi(ax[j].x) + (p1l[1] + p2l[1]) * YI; va[j].z = bflo(ax[j].y) + (p1h[0] + p2h[0]) * YI; va[j].w = bfhi(ax[j].y) + (p1h[1] + p2h[1]) * YI; }
            { const auto p1l = __builtin_amdgcn_cvt_pk_f32_fp8((int)b1[j], false), p1h = __builtin_amdgcn_cvt_pk_f32_fp8((int)b1[j], true), p2l = __builtin_amdgcn_cvt_pk_f32_fp8((int)b2[j], false), p2h = __builtin_amdgcn_cvt_pk_f32_fp8((int)b2[j], true);
              vb[j].x = bflo(bx[j].x) + (p1l[0] + p2l[0]) * YI; vb[j].y = bfhi(bx[j].x) + (p1l[1] + p2l[1]) * YI; vb[j].z = bflo(bx[j].y) + (p1h[0] + p2h[0]) * YI; vb[j].w = bfhi(bx[j].y) + (p1h[1] + p2h[1]) * YI; }
            sa += (va[j].x * va[j].x + va[j].y * va[j].y) + (va[j].z * va[j].z + va[j].w * va[j].w); sb += (vb[j].x * vb[j].x + vb[j].y * vb[j].y) + (vb[j].z * vb[j].z + vb[j].w * vb[j].w); }
        const float ra = 1.f / sqrtf(wave_sum(sa) * (1.f / D) + NORM_EPS), rb = 1.f / sqrtf(wave_sum(sb) * (1.f / D) + NORM_EPS);
        f32x4* oa = (f32x4*)(OUT + (size_t)m * D) + lane; f32x4* ob = (f32x4*)(OUT + (size_t)mb * D) + lane;
#pragma unroll
        for (int j = 0; j < 4; ++j) { const f32x4 g = gv[j]; oa[64 * j] = va[j] * ra * g; if (has2) ob[64 * j] = vb[j] * rb * g; }
    }
}

struct Args { const void* in[30]; float* out; unsigned char* ws; int ph_lo, ph_hi; };
enum { IN_X = 0, IN_POS, IN_MIXG, IN_WIN, IN_MU, IN_W0, IN_WUP, IN_A0, IN_AUP, IN_GUP, IN_KK, IN_KA, IN_RK, IN_GNW, IN_GNB, IN_GQA, IN_WQUP, IN_GKVA, IN_WKVUP,
       IN_WBR, IN_WBM, IN_WOUT, IN_FFNG, IN_WGRP, IN_BGRP, IN_WRT, IN_BRT, IN_WGU, IN_WDN, IN_FING };

__global__ void __launch_bounds__(NWAVES * 64, 2) hybrid_fwd(Args args) {
    extern __shared__ __attribute__((aligned(16))) unsigned char lds[];
    Frame F;
    F.lds = (LAS unsigned char*)lds;
    F.tid = threadIdx.x; F.lane = F.tid & 63; F.wave = __builtin_amdgcn_readfirstlane(F.tid >> 6);
    F.G = gridDim.x; { const int bx = blockIdx.x; F.vcu = (F.G % 8 == 0) ? (bx % 8) * (F.G / 8) + bx / 8 : bx; }
    F.out = args.out; F.ws = args.ws; F.ctl = (gu32*)(args.ws + WS_CTL); F.in = nullptr;
    unsigned char* ws = args.ws;
    for (int u = F.tid; u < 256; u += NWAVES * 64) ((LAS unsigned*)(F.lds + MISC_OFF))[u] = 0u;
    __syncthreads();
    XcdBarrier bar; bar.bar = (unsigned*)(F.ctl + CW_BAR); bar.x = 0; bar.st = nullptr;
    if (N_LAUNCHES == 1) bar = xcd_barrier_post((unsigned*)(F.ctl + CW_BAR), (volatile LAS unsigned*)(F.lds + MISC_OFF));
#define GRID_BAR() do { if (N_LAUNCHES == 1) xcd_barrier(bar); } while (0)
#define GRID_ARRIVE() do { if (N_LAUNCHES == 1) xcd_barrier_arrive(bar); } while (0)
#define GRID_WAIT() do { if (N_LAUNCHES == 1) xcd_barrier_wait(bar); } while (0)
    const int lo = args.ph_lo, hi = args.ph_hi;
#ifndef PHASE_MASK
#define PHASE_MASK 0xFFFF
#endif
#define IN(k) ((((PHASE_MASK) >> (k)) & 1) && lo <= (k) && (k) < hi)
#define BOTH(k) (IN(k) && IN((k) + 1))
#define INF(i) ((const float*)args.in[i])
    LAS unsigned char* ring = F.lds;
    const int bx = (int)blockIdx.x;

    if (IN(0)) {
        P0In I{INF(IN_FFNG), INF(IN_X), INF(IN_MIXG), INF(IN_WIN), INF(IN_WUP), INF(IN_AUP), INF(IN_GUP), INF(IN_GQA), INF(IN_WQUP), INF(IN_GKVA), INF(IN_WKVUP), INF(IN_WBR), INF(IN_WBM), INF(IN_WOUT),
               INF(IN_WGRP), INF(IN_WRT), INF(IN_WGU), INF(IN_WDN), (const int*)args.in[IN_POS]};
        p0_prologue(F, I);
        if (BOTH(0)) GRID_BAR();
    }
    if (IN(1)) {
        { pg8::Gemm g{(const bf16*)(ws + WS_XN), (const bf16*)(ws + WS_WIN) + (size_t)2048 * D, D, D, D, 0, nullptr}; pg8::StaticOrder S; S.init(M, NRWM, F.G, bx);
          EpiP1 E{(bf16*)(ws + WS_RKV), (bf16*)(ws + WS_REST)};
          pg8::gemm_phase<EpiP1, pg8::StaticOrder, true, false>(ring, g, S, E); }
        { pg8::Gemm g{(const bf16*)(ws + WS_XN8), (const bf16*)(ws + WS_WIN8 + (size_t)1024 * D), D / 2, D / 2, D / 2, 0, nullptr}; pg8::StaticOrder S; S.init(M, D, F.G, bx);
          EpiGate8 E{ws + WS_GATEB};
          pg8::gemm_phase<EpiGate8, pg8::StaticOrder, true, false, false, true>(ring, g, S, E); }
        if (BOTH(1)) GRID_ARRIVE();
    }
    if (IN(2)) {
        P2In I{INF(IN_MU), INF(IN_W0), INF(IN_A0)};
        p2_prep(F, I, bar, N_LAUNCHES == 1 && BOTH(1));
        if (BOTH(2)) GRID_ARRIVE();
    }
    const bool split34 = false;
    if (IN(3)) {
#ifndef P3SEL
#define P3SEL 7
#endif
        if (!(split34 && F.vcu < F.G / 2)) {
        if (P3SEL & 1) { pg8::Gemm g{(const bf16*)(ws + WS_REST) + R_Q, (const bf16*)(ws + WS_WQ), QL, NREST, QL, 0, nullptr}; pg8::StaticOrder S; if (split34) S.init(M, QPITCH, F.G / 2, F.vcu - F.G / 2); else S.init(M, QPITCH, F.G, bx);
          EpiQ E{(bf16*)(ws + WS_Q), (const float*)(ws + WS_SQ), (const float*)(ws + WS_COS), (const float*)(ws + WS_SIN)};
          pg8::gemm_phase<EpiQ, pg8::StaticOrder, true, false, false, false, BarWait>(ring, g, S, E, BarWait{bar, N_LAUNCHES == 1 && BOTH(2)}); }
        if (P3SEL & 2) { pg8::Gemm g{(const bf16*)(ws + WS_REST) + R_KV, (const bf16*)(ws + WS_WKN), KVL, NREST, KVL, 0, nullptr};
          const int nq2 = (M / 256) * (QPITCH / 256) - F.G;
          pg8::RangeOrder S{0, 0, 4};
          if (split34) { S.base = (F.vcu - F.G / 2) * 4; S.cnt = 4; }
          else if (F.G == 256 && nq2 == 128) { if (bx < 128) { S.base = bx; S.cnt = 1; } else { S.base = 128 + (bx - 128) * 3; S.cnt = 3; } }
          else { S.base = bx * ((M / 256) * 4 / F.G); S.cnt = (M / 256) * 4 / F.G; if (bx == F.G - 1) S.cnt = (M / 256) * 4 - S.base; }
          EpiKn E{(bf16*)(ws + WS_K), (const float*)(ws + WS_SKV)};
          pg8::gemm_phase<EpiKn, pg8::RangeOrder, true, false>(ring, g, S, E); }
        }
        if (BOTH(3)) { if ((split34 || (F.G == 256 && N_LAUNCHES == 1)) && F.vcu < F.G / 2) GRID_ARRIVE(); else GRID_BAR(); }
    }
    if (IN(4)) {
        const int nb = BATCH * NH, half = F.G / 2;
        if (F.vcu < half) { ScanIn I{INF(IN_MU), INF(IN_KK), INF(IN_KA), INF(IN_RK), INF(IN_GNW), INF(IN_GNB)}; for (int bh = F.vcu; bh < nb; bh += half) scan_phase(F, I, bh); if (BOTH(3) && (split34 || (F.G == 256 && N_LAUNCHES == 1))) GRID_WAIT(); }
        else { for (int bh = F.vcu - half; bh < nb; bh += F.G - half) attn_phase(F, bh); }
        { pg8::Gemm g{(const bf16*)(ws + WS_XN8), (const bf16*)(ws + WS_WIN8), D / 2, D / 2, D / 2, 0, nullptr};
          EpiGate8 E{ws + WS_GATEA};
          volatile LAS int* qw = (volatile LAS int*)(F.lds + MISC_OFF + 32);
          constexpr int NU = (M / 256) * 4;
          const int nstat = ((F.G - half) * 4 <= NU && F.G == 2 * half) ? (F.G - half) * 4 : 0;
          if (nstat) { pg8::RangeOrder S{F.vcu >= half ? (F.vcu - half) * 4 : 0, F.vcu >= half ? 4 : 0, 4};
            if (split34) { S.base = F.vcu < half ? F.vcu * 4 : 0; S.cnt = F.vcu < half ? 4 : 0; }
            pg8::gemm_phase<EpiGate8, pg8::RangeOrder, true, false, false, true>(ring, g, S, E); }
          if (nstat < NU)
          for (;;) {
              __syncthreads();
              if (F.tid == 0) { const unsigned sz = nstat ? 1u : 2u;
                  qw[0] = nstat + (int)__hip_atomic_fetch_add((unsigned*)(F.ctl + CW_GQ), sz, RLX_AGENT); qw[1] = (int)sz; }
              __syncthreads();
              const int L = qw[0]; int n = qw[1];
              if (L >= NU) break;
              if (L + n > NU) n = NU - L;
              pg8::RangeOrder S{L, n, 4};
              pg8::gemm_phase<EpiGate8, pg8::RangeOrder, true, false, false, true>(ring, g, S, E);
          } }
        if (BOTH(4)) GRID_ARRIVE();
    }
    if (IN(5)) {
        bf16* MG = (bf16*)(ws + WS_MERGED);
        if (N_LAUNCHES == 1 && F.G == 256 && BOTH(4)) { constexpr int CUT = MOEW_SPLIT + (MOEW_ITEMS - MOEW_SPLIT) * 3 / 4; const int hf = F.G / 2;
            if (F.vcu < hf) p5_moe_weights(F, INF(IN_WGU), INF(IN_WDN), INF(IN_FFNG), F.vcu, hf, MOEW_SPLIT, CUT);
            else p5_moe_weights(F, INF(IN_WGU), INF(IN_WDN), INF(IN_FFNG), F.vcu - hf, hf, CUT, MOEW_ITEMS); }
        else p5_moe_weights(F, INF(IN_WGU), INF(IN_WDN), INF(IN_FFNG), F.vcu, F.G, MOEW_SPLIT, MOEW_ITEMS);
        { float* SS = (float*)(ws + WS_SQ); for (int i = F.vcu * (NWAVES * 64) + F.tid; i < M; i += F.G * NWAVES * 64) SS[i] = 0.f; }
        if (BOTH(4)) GRID_WAIT();
        __syncthreads();
        pg8::StaticOrder S; S.init(M, D, F.G, bx);
        { pg8::Gemm g{(const bf16*)(ws + WS_YCAT), (const bf16*)(ws + WS_WBR), D, D, D, 0, nullptr}; EpiMerge2 E{ws + WS_GATEA, ws + WS_GATEB, MG};
          pg8::gemm_phase<EpiMerge2, pg8::StaticOrder, true, false, true>(ring, g, S, E); }
        if (BOTH(5)) GRID_BAR();
    }
    if (IN(6)) {
        pg8::Gemm g{(const bf16*)(ws + WS_MERGED), (const bf16*)(ws + WS_WO), D / 2, D / 2, D / 2, 0, nullptr}; pg8::StaticOrder S; S.init(M, D, F.G, bx);
        EpiXmid E{(const float*)(ws + WS_RINV), (bf16*)(ws + WS_XN), (float*)(ws + WS_SQ), ws + WS_XN8};
        pg8::gemm_phase<EpiXmid, pg8::StaticOrder, true, false, false, true>(ring, g, S, E);
        if (BOTH(6)) GRID_BAR();
    }
    if (IN(8)) {
        pg8::Gemm g{(const bf16*)(ws + WS_XN), (const bf16*)(ws + WS_WR), D, D, D, 0, nullptr}; pg8::StaticOrder S; S.init(M, 256, F.G, bx);
        EpiLogits E{(float*)(ws + WS_LOGITS), (const float*)(ws + WS_SQ)};
        pg8::gemm_phase<EpiLogits, pg8::StaticOrder, true, false>(ring, g, S, E);
        if (bx >= S.nwg && F.G > S.nwg) p5_moe_weights(F, INF(IN_WGU), INF(IN_WDN), INF(IN_FFNG), bx - S.nwg, F.G - S.nwg, 0, MOEW_SPLIT);
        else if (F.G <= S.nwg) p5_moe_weights(F, INF(IN_WGU), INF(IN_WDN), INF(IN_FFNG), F.vcu, F.G, 0, MOEW_SPLIT);
        VM_WAIT(); __syncthreads();
        pg8::Unit u; for (int i = 0; S.next(i, u); ++i) { p9_route(F, INF(IN_BGRP), INF(IN_BRT), u.pm * 256, 256); __syncthreads(); }
        if (BOTH(8)) GRID_BAR();
    }
    if (IN(11)) {
        moe_offsets(F);
        const LAS int* PE = (const LAS int*)(F.lds + MISC_OFF + 64); const int nblk = PE[31], nfull = nblk < 256 ? nblk : 256;
        pg8::Gemm g{(const bf16*)(ws + WS_XN8), (const bf16*)(ws + WS_WGU), D / 2, D / 2, D / 2, (size_t)512 * D / 2, (const int*)(ws + WS_TOK2)};
        pg8::MoeList S{PE, 2, bx, F.G, nfull * 2};
        EpiSwiglu E{(bf16*)(ws + WS_ACT), (const float*)(ws + WS_RSB2)};
        pg8::gemm_phase<EpiSwiglu, pg8::MoeList, true, true, false, true>(ring, g, S, E);
        if (BOTH(11)) GRID_BAR();
    }
    if (IN(12)) {
        if (!IN(11)) moe_offsets(F);
        const LAS int* PE = (const LAS int*)(F.lds + MISC_OFF + 64); const int nblk = PE[31], ntail = nblk > 256 ? nblk - 256 : 0, nch = 2 * ntail < F.G ? 2 * ntail : 0;
        const bool chain = bx < nch; const int rbT = 256 + (bx >> 1), hf = bx & 1;
        if (chain) {
            pg8::Gemm g{(const bf16*)(ws + WS_XN8), (const bf16*)(ws + WS_WGU), D / 2, D / 2, D / 2, (size_t)512 * D / 2, (const int*)(ws + WS_TOK2)};
            pg8::MoeList S{PE, 2, rbT * 2 + hf, 1, rbT * 2 + hf + 1};
            EpiSwiglu E{(bf16*)(ws + WS_ACT), (const float*)(ws + WS_RSB2)};
            pg8::gemm_phase<EpiSwiglu, pg8::MoeList, true, true, false, true>(ring, g, S, E);
            pair_barrier((unsigned*)(F.ctl + CW_PAIR + (bx >> 1) * 64), (unsigned*)(F.ctl + CW_BAR));
        }
        pg8::Gemm g{(const bf16*)(ws + WS_ACT), (const bf16*)(ws + WS_WD), DEXP / 2, DEXP / 2, DEXP / 2, (size_t)D * DEXP / 2, nullptr};
        pg8::MoeList S{PE, 4, chain ? rbT * 4 + 2 * hf : bx - nch, chain ? 1 : F.G - nch, chain ? rbT * 4 + 2 * hf + 2 : (nblk < 256 ? nblk : 256) * 4};
        EpiDown E{(bf16*)(ws + WS_Y), (const float*)(ws + WS_WB2)};
        pg8::gemm_phase<EpiDown, pg8::MoeList, true, false, false, true>(ring, g, S, E);
        if (BOTH(12)) GRID_ARRIVE();
    }
    if (IN(13)) { if (!IN(11)) moe_offsets(F); p13_final(F, INF(IN_FING), bar, N_LAUNCHES == 1 && BOTH(12)); }
#undef IN
#undef BOTH
#undef INF
#undef GRID_BAR
}

extern "C" void kernel_launch(void* const* d_in, const int* in_sizes, int n_in, void* d_out, int out_size, void* d_ws, size_t ws_size, hipStream_t stream) {
    static int grid = 0;
    if (grid == 0) {
        if (n_in != 30 || in_sizes[0] != M * D || out_size != M * D || ws_size < WS_END) { fprintf(stderr, "kernel_launch: unexpected shapes (n_in %d, in0 %d, out %d, ws %zu); nothing launched\n", n_in, n_in > 0 ? in_sizes[0] : -1, out_size, ws_size); grid = -1; return; }
        int dev = 0, cus = 0, per_cu = 0;
        if (hipGetDevice(&dev) != hipSuccess || hipDeviceGetAttribute(&cus, hipDeviceAttributeMultiprocessorCount, dev) != hipSuccess) { grid = -1; return; }
        if (hipFuncSetAttribute((const void*)hybrid_fwd, hipFuncAttributeMaxDynamicSharedMemorySize, LDS_BYTES) != hipSuccess) { fprintf(stderr, "kernel_launch: hipFuncSetAttribute failed\n"); grid = -1; return; }
        if (hipOccupancyMaxActiveBlocksPerMultiprocessor(&per_cu, (const void*)hybrid_fwd, NWAVES * 64, LDS_BYTES) != hipSuccess || per_cu < 1)
            fprintf(stderr, "kernel_launch: note: occupancy query reports %d workgroups per CU\n", per_cu);
        (void)hipGetLastError();
        grid = cus;
        if (grid != 256) fprintf(stderr, "kernel_launch: note: %d CUs\n", grid);
    }
    if (grid < 0) return;
    if (hipMemsetAsync((char*)d_ws + WS_CTL, 0, CTL_ZERO_BYTES, stream) != hipSuccess) return;
    Args a{};
    for (int i = 0; i < 30; ++i) a.in[i] = d_in[i];
    a.out = (float*)d_out; a.ws = (unsigned char*)d_ws;
    if (N_LAUNCHES == 1) { a.ph_lo = 0; a.ph_hi = NPH; hipLaunchKernelGGL(hybrid_fwd, dim3(grid), dim3(NWAVES * 64), LDS_BYTES, stream, a); }
    else for (int p = 0; p < NPH; ++p) { a.ph_lo = p; a.ph_hi = p + 1; hipLaunchKernelGGL(hybrid_fwd, dim3(grid), dim3(NWAVES * 64), LDS_BYTES, stream, a); }
}
```
